# Optimizing an MI355X kernel written in HIP

```python
import math
import jax, jax.numpy as jnp
from jax import lax
import numpy as np

D_MODEL = 1024
BATCH = 1
SEQ = 16384
DEPTH = 1
DEC_BATCH = 2
DEC_SEQ = 8192
PAST_LEN = 128

N_GROUPS = 3
WINDOWS = (128, 512, 2048)
DILATIONS = (1, 4, 16)
HEADS_PER_GROUP = 8
HEAD_DIM = 64
ATTN_WIDTH = HEADS_PER_GROUP * HEAD_DIM
QKV_WIDTH = N_GROUPS * ATTN_WIDTH
CONV_WIDTH = 512
CONV_K = 3
N_BRANCH = 2
IN_WIDTH = 3 * QKV_WIDTH + ATTN_WIDTH + 4 * CONV_WIDTH + N_BRANCH * D_MODEL
RMS_EPS = 1e-6
NEG_BIG = -1e30

kernel_name = "hybrid_dilated_attn_shortconv_encoder"


def _alibi_slopes():
    n = N_GROUPS * HEADS_PER_GROUP
    s = 2.0 ** (-8.0 * np.arange(1, n + 1) / n)
    return jnp.asarray(s.astype(np.float32).reshape(N_GROUPS, HEADS_PER_GROUP))


def _split_points():
    sizes = [QKV_WIDTH, QKV_WIDTH, QKV_WIDTH, ATTN_WIDTH,
             CONV_WIDTH, CONV_WIDTH, CONV_WIDTH, CONV_WIDTH, N_BRANCH * D_MODEL]
    return [int(v) for v in np.cumsum(sizes)[:-1]]


def _rmsnorm(x, g):
    xf = x.astype(jnp.float32)
    y = xf * lax.rsqrt(jnp.mean(xf * xf, axis=-1, keepdims=True) + RMS_EPS) * g.astype(jnp.float32)
    return y.astype(x.dtype)


def _dilated_band_attention(q, k, v, dil, radius, slopes):
    B, S, H, Dh = q.shape
    L = S // dil
    blk = radius
    nb = -(-L // blk)
    Lp = nb * blk

    def to_res(t):
        return t.reshape(B, L, dil, H, Dh).transpose(0, 2, 1, 3, 4)

    qr, kr, vr = to_res(q), to_res(k), to_res(v)
    qb = jnp.pad(qr, ((0, 0), (0, 0), (0, Lp - L), (0, 0), (0, 0))).reshape(B, dil, nb, blk, H, Dh)

    def key_windows(t):
        tp = jnp.pad(t, ((0, 0), (0, 0), (blk, blk + Lp - L), (0, 0), (0, 0)))
        tb = tp.reshape(B, dil, nb + 2, blk, H, Dh)
        return jnp.concatenate([tb[:, :, :-2], tb[:, :, 1:-1], tb[:, :, 2:]], axis=3)

    kw, vw = key_windows(kr), key_windows(vr)
    s = jnp.einsum('brnqhd,brnkhd->brhnqk', qb, kw,
                   preferred_element_type=jnp.float32) * (1.0 / math.sqrt(Dh))

    n_idx = jnp.arange(nb)[:, None, None]
    qpos = n_idx * blk + jnp.arange(blk)[None, :, None]
    kpos = (n_idx - 1) * blk + jnp.arange(3 * blk)[None, None, :]
    rel = jnp.abs(kpos - qpos)
    valid = (rel <= radius) & (kpos >= 0) & (kpos < L)
    dist = (rel * dil).astype(jnp.float32)
    bias = -slopes[:, None, None, None] * dist[None]
    s = jnp.where(valid, s + bias, NEG_BIG)

    m = jnp.max(s, axis=-1, keepdims=True)
    p = jnp.exp(s - m)
    den = jnp.sum(p, axis=-1)
    o = jnp.einsum('brhnqk,brnkhd->brnqhd', p, vw.astype(jnp.float32))
    o = o / jnp.transpose(den, (0, 1, 3, 4, 2))[..., None]
    lse = (m[..., 0] + jnp.log(den)).transpose(0, 1, 3, 4, 2)

    o = o.reshape(B, dil, Lp, H, Dh)[:, :, :L].transpose(0, 2, 1, 3, 4).reshape(B, S, H, Dh)
    lse = lse.reshape(B, dil, Lp, H)[:, :, :L].transpose(0, 2, 1, 3).reshape(B, S, H)
    return o, lse


def _layer(x, norm_g, w_in, b_gate, conv_w, w_attn_out, w_conv_out, w_o):
    B, S, _ = x.shape
    hn = _rmsnorm(x, norm_g)
    proj = jnp.einsum('bsd,de->bse', hn, w_in)
    q, k, v, z_a, hc, gb, gc, z_b, g = jnp.split(proj, _split_points(), axis=-1)

    shp = (B, S, N_GROUPS, HEADS_PER_GROUP, HEAD_DIM)
    q, k, v = q.reshape(shp), k.reshape(shp), v.reshape(shp)
    slopes = _alibi_slopes()
    outs, lses = [], []
    for gi in range(N_GROUPS):
        dil = DILATIONS[gi]
        radius = WINDOWS[gi] // (2 * dil)
        o, l = _dilated_band_attention(q[:, :, gi], k[:, :, gi], v[:, :, gi], dil, radius, slopes[gi])
        outs.append(o)
        lses.append(l)
    wts = jax.nn.softmax(jnp.stack(lses), axis=0)
    attn = jnp.einsum('gbsh,gbshd->bshd', wts, jnp.stack(outs))
    attn = attn.reshape(B, S, ATTN_WIDTH).astype(x.dtype)
    a = jnp.einsum('bsc,cd->bsd', jax.nn.silu(z_a) * attn, w_attn_out)

    u = gc * hc
    up = jnp.pad(u, ((0, 0), (1, 1), (0, 0)))
    conv = conv_w[0] * up[:, :-2] + conv_w[1] * up[:, 1:-1] + conv_w[2] * up[:, 2:]
    c = jnp.einsum('bsc,cd->bsd', jax.nn.silu(z_b) * (gb * conv), w_conv_out)

    gates = jax.nn.sigmoid(g + b_gate)
    g_a, g_c = jnp.split(gates, N_BRANCH, axis=-1)
    merged = g_a * a + g_c * c
    return x + jnp.einsum('bsd,de->bse', merged, w_o)


def setup_inputs(seed: int = 0) -> dict:
    key = jax.random.key(seed)
    ks = jax.random.split(key, 10)
    f32 = jnp.float32
    x_prompt = jax.random.normal(ks[0], (BATCH, SEQ, D_MODEL), f32)
    x_sample = jax.random.normal(ks[1], (DEC_BATCH, DEC_SEQ, D_MODEL), f32)
    norm_g = 1.0 + 0.02 * jax.random.normal(ks[2], (DEPTH, D_MODEL), f32)
    w_in = jax.random.normal(ks[3], (DEPTH, D_MODEL, IN_WIDTH), f32) * D_MODEL ** -0.5
    b_gate = 0.01 * jax.random.normal(ks[4], (DEPTH, N_BRANCH * D_MODEL), f32)
    conv_w = jax.random.normal(ks[5], (DEPTH, CONV_K, CONV_WIDTH), f32) * CONV_K ** -0.5
    w_attn_out = jax.random.normal(ks[6], (DEPTH, ATTN_WIDTH, D_MODEL), f32) * ATTN_WIDTH ** -0.5
    w_conv_out = jax.random.normal(ks[7], (DEPTH, CONV_WIDTH, D_MODEL), f32) * CONV_WIDTH ** -0.5
    w_o = jax.random.normal(ks[8], (DEPTH, D_MODEL, D_MODEL), f32) * D_MODEL ** -0.5
    final_g = 1.0 + 0.02 * jax.random.normal(ks[9], (D_MODEL,), f32)
    return {"x_prompt": x_prompt, "x_sample": x_sample, "norm_g": norm_g, "w_in": w_in,
            "b_gate": b_gate, "conv_w": conv_w, "w_attn_out": w_attn_out,
            "w_conv_out": w_conv_out, "w_o": w_o, "final_g": final_g}


def reference(x_prompt, x_sample, norm_g, w_in, b_gate, conv_w, w_attn_out, w_conv_out, w_o, final_g):
    hp, hs = x_prompt, x_sample
    for l in range(DEPTH):
        hp = _layer(hp, norm_g[l], w_in[l], b_gate[l], conv_w[l], w_attn_out[l], w_conv_out[l], w_o[l])
        hs = _layer(hs, norm_g[l], w_in[l], b_gate[l], conv_w[l], w_attn_out[l], w_conv_out[l], w_o[l])
    y_prompt = _rmsnorm(hp, final_g)
    y_sample = _rmsnorm(hs, final_g)
    return (y_prompt, y_sample)
```

```cpp
#include <hip/hip_runtime.h>
#include <hip/hip_cooperative_groups.h>
#include <cstdio>
#include <cstdint>
namespace cg = cooperative_groups;
namespace pg8 {
#define PG8_LAS __attribute__((address_space(3)))
typedef unsigned short bf16_t;
typedef short bf16x8 __attribute__((ext_vector_type(8)));
typedef float f32x4 __attribute__((ext_vector_type(4)));
typedef unsigned u32x4 __attribute__((ext_vector_type(4)));
constexpr int BM = 256, BK = 64, HALF = 128, HTB = HALF * BK * 2  , STAGE_BYTES = 8 * HTB, NXCD = 8, WGM = 8;

__host__ __device__ __forceinline__ int lds_byte(int r, int c) { const int st = (r >> 4) * 2 + (c >> 5), rr = r & 15, cc = c & 31, ob = rr * 64 + cc * 2; return st * 1024 + (ob ^ (((ob >> 9) & 1) << 5)); }
__host__ __device__ __forceinline__ void stage_rc(int b, int& R, int& C) { const int st = b / 1024, sb = b % 1024, swz = sb ^ (((sb >> 9) & 1) << 5); R = (st >> 1) * 16 + swz / 64; C = (st & 1) * 32 + (swz % 64) / 2; }
__host__ __device__ __forceinline__ int perm32(int rho) { const int n = rho >> 4, i = rho & 15; return 8 * (i >> 2) + 4 * n + (i & 3); }

struct Unit { int pm, pn; };
struct Gemm { const bf16_t* A; const bf16_t* Bt; int M, N, K; };

struct StaticOrder {
    int nM, nN, nwg, G, c;
    __host__ __device__ void init(int M, int N, int G_, int c_) { nM = M / BM; nN = N / BM; nwg = nM * nN; G = G_; c = c_; }
    __host__ __device__ bool next(int i, Unit& u) const {
        const long L = (long)i * G + c; if (L >= nwg) return false;
        int wgid = (int)L; { const int q = nwg / NXCD, r = nwg % NXCD, xcd = wgid % NXCD, off = wgid / NXCD; wgid = (xcd < r ? xcd * (q + 1) : r * (q + 1) + (xcd - r) * q) + off; }
        const int nig = WGM * nN, gid = wgid / nig, fm = gid * WGM, gsz = (nM - fm) < WGM ? (nM - fm) : WGM;
        u.pm = fm + ((wgid % nig) % gsz); u.pn = (wgid % nig) / gsz; return true;
    }
    __device__ __forceinline__ void a_ready(const Unit&) const {}
    __device__ __forceinline__ void done(const Unit&) const {}
};
__device__ __forceinline__ unsigned cvt_pk_bf16(float lo, float hi) { unsigned r; asm volatile("v_cvt_pk_bf16_f32 %0, %1, %2" : "=v"(r) : "v"(lo), "v"(hi)); return r; }
__device__ __forceinline__ float bf_lo(unsigned w) { return __builtin_bit_cast(float, w << 16); }
__device__ __forceinline__ float bf_hi(unsigned w) { return __builtin_bit_cast(float, w & 0xffff0000u); }
__device__ __forceinline__ float sigmoid_f(float x) { x = fminf(fmaxf(x, -30.f), 30.f); return __builtin_amdgcn_rcpf(1.f + __expf(-x)); }
__device__ __forceinline__ f32x4 exp2n4(const f32x4& v) { const f32x4 t = v * (-1.4426950408889634f); f32x4 e; e[0] = __builtin_amdgcn_exp2f(t[0]); e[1] = __builtin_amdgcn_exp2f(t[1]); e[2] = __builtin_amdgcn_exp2f(t[2]); e[3] = __builtin_amdgcn_exp2f(t[3]); return e; }
__device__ __forceinline__ f32x4 rcp4(const f32x4& d) { f32x4 r; r[0] = __builtin_amdgcn_rcpf(d[0]); r[1] = __builtin_amdgcn_rcpf(d[1]); r[2] = __builtin_amdgcn_rcpf(d[2]); r[3] = __builtin_amdgcn_rcpf(d[3]); return r; }
__device__ __forceinline__ f32x4 silu4(const f32x4& v) { return v * rcp4(exp2n4(v) + 1.f); }
__device__ __forceinline__ u32x4 pack8(const f32x4& a, const f32x4& b) { u32x4 w; w.x = cvt_pk_bf16(a[0], a[1]); w.y = cvt_pk_bf16(a[2], a[3]); w.z = cvt_pk_bf16(b[0], b[1]); w.w = cvt_pk_bf16(b[2], b[3]); return w; }
__device__ __forceinline__ void unpack8(const u32x4& w, f32x4& a, f32x4& b) { a[0] = bf_lo(w.x); a[1] = bf_hi(w.x); a[2] = bf_lo(w.y); a[3] = bf_hi(w.y); b[0] = bf_lo(w.z); b[1] = bf_hi(w.z); b[2] = bf_lo(w.w); b[3] = bf_hi(w.w); }

__device__ __forceinline__ void st16_wt(__amdgpu_buffer_rsrc_t r, unsigned byte_off, u32x4 v) { __builtin_amdgcn_raw_buffer_store_b128(v, r, byte_off, 0, 16); }
__device__ __forceinline__ unsigned dpp_swap1(unsigned v) { unsigned r; asm volatile("s_nop 1\n\tv_mov_b32_dpp %0, %1 quad_perm:[1,0,3,2] row_mask:0xf bank_mask:0xf bound_ctrl:1" : "=v"(r) : "v"(v)); return r; }
__device__ __forceinline__ void store_lines(bf16_t* rowp_even, int pitch, bool odd, const u32x4& P0, const u32x4& P1) {
    u32x4 snd, rcv;
#pragma unroll
    for (int k = 0; k < 4; ++k) snd[k] = odd ? P0[k] : P1[k];
#pragma unroll
    for (int k = 0; k < 4; ++k) rcv[k] = dpp_swap1(snd[k]);
    u32x4 A, B;
#pragma unroll
    for (int k = 0; k < 4; ++k) { A[k] = odd ? rcv[k] : P0[k]; B[k] = odd ? P1[k] : rcv[k]; }
    bf16_t* p = rowp_even + (odd ? 32 : 0);
    *(u32x4*)p = A; *(u32x4*)(p + pitch) = B;
}
__device__ __forceinline__ void store_lines_f32_nt(float* rowp_even, int pitch, bool odd, const f32x4& P0, const f32x4& P1) {
    f32x4 snd, rcv, A, B;
#pragma unroll
    for (int k = 0; k < 4; ++k) snd[k] = odd ? P0[k] : P1[k];
#pragma unroll
    for (int k = 0; k < 4; ++k) rcv[k] = __shfl_xor(snd[k], 1);
#pragma unroll
    for (int k = 0; k < 4; ++k) { A[k] = odd ? rcv[k] : P0[k]; B[k] = odd ? P1[k] : rcv[k]; }
    float* p = rowp_even + (odd ? 16 : 0);
    __builtin_nontemporal_store(A, (f32x4*)p); __builtin_nontemporal_store(B, (f32x4*)(p + pitch));
}
__device__ __forceinline__ void load_lines_f32_nt(const float* rowp_even, int pitch, bool odd, f32x4& P0, f32x4& P1) {
    const float* p = rowp_even + (odd ? 16 : 0);
    const f32x4 A = __builtin_nontemporal_load((const f32x4*)p), B = __builtin_nontemporal_load((const f32x4*)(p + pitch));
    f32x4 snd, rcv;
#pragma unroll
    for (int k = 0; k < 4; ++k) snd[k] = odd ? A[k] : B[k];
#pragma unroll
    for (int k = 0; k < 4; ++k) rcv[k] = __shfl_xor(snd[k], 1);
#pragma unroll
    for (int k = 0; k < 4; ++k) { P0[k] = odd ? rcv[k] : A[k]; P1[k] = odd ? B[k] : rcv[k]; }
}
constexpr float QSCALE = 0.125f * 1.4426950408889634f;

struct EpiP1 {
    static constexpr bool PERM = true, AFTER_DRAIN = false;
    bf16_t *QKV, *ZA, *U, *T, *GR, *GC; const float* b_gate; int pn_off;
    __device__ __forceinline__ void acc_init(f32x4 (&acc)[2][2][4][2], const Unit&, int, int, int, int) const {
#pragma unroll
        for (int a = 0; a < 2; ++a)
#pragma unroll
            for (int b = 0; b < 2; ++b)
#pragma unroll
                for (int m = 0; m < 4; ++m)
#pragma unroll
                    for (int n = 0; n < 2; ++n) acc[a][b][m][n] = (f32x4){0.f, 0.f, 0.f, 0.f};
    }
    __device__ __forceinline__ bool keep(const Unit&) const { return false; }
    __device__ __forceinline__ void operator()(f32x4 (&acc)[2][2][4][2], const Unit& u, int wr, int wc, int fr, int fq) const {
        const int row0 = u.pm * BM + wr * 64 + fr, cl = wc * 32 + 8 * fq, pn = u.pn + pn_off;
        const int rowe0 = u.pm * BM + wr * 64 + (fr & ~1), cl2 = wc * 64 + 8 * fq; const bool odd = fr & 1;
        if (pn < 18) {
            const float sc = pn < 6 ? QSCALE : 1.f;
#pragma unroll
            for (int ai = 0; ai < 2; ++ai)
#pragma unroll
                for (int m = 0; m < 4; ++m) { bf16_t* rowe = QKV + (size_t)(rowe0 + ai * HALF + m * 16) * 4608 + pn * 256 + cl2;
                    store_lines(rowe, 4608, odd, pack8(acc[ai][0][m][0] * sc, acc[ai][0][m][1] * sc), pack8(acc[ai][1][m][0] * sc, acc[ai][1][m][1] * sc)); }
        } else if (pn < 20) {
#pragma unroll
            for (int ai = 0; ai < 2; ++ai)
#pragma unroll
                for (int m = 0; m < 4; ++m) { bf16_t* rowe = ZA + (size_t)(rowe0 + ai * HALF + m * 16) * 512 + (pn - 18) * 256 + cl2;
                    u32x4 pz[2];
#pragma unroll
                    for (int bj = 0; bj < 2; ++bj) { f32x4 v0 = acc[ai][bj][m][0], v1 = acc[ai][bj][m][1];
                        { v0 = silu4(v0); v1 = silu4(v1); }
                        pz[bj] = pack8(v0, v1); }
                    store_lines(rowe, 512, odd, pz[0], pz[1]); }
        } else if (pn < 24) {
#pragma unroll
            for (int ai = 0; ai < 2; ++ai)
#pragma unroll
                for (int m = 0; m < 4; ++m) { bf16_t* rowp = U + (size_t)(row0 + ai * HALF + m * 16) * 512 + (pn - 20) * 128 + cl;
                    *(u32x4*)rowp = pack8(acc[ai][0][m][0] * acc[ai][1][m][0], acc[ai][0][m][1] * acc[ai][1][m][1]); }
        } else if (pn < 28) {
#pragma unroll
            for (int ai = 0; ai < 2; ++ai)
#pragma unroll
                for (int m = 0; m < 4; ++m) { bf16_t* rowp = T + (size_t)(row0 + ai * HALF + m * 16) * 512 + (pn - 24) * 128 + cl;
                    f32x4 v0 = acc[ai][1][m][0], v1 = acc[ai][1][m][1];
                    { v0 = silu4(v0); v1 = silu4(v1); }
                    *(u32x4*)rowp = pack8(acc[ai][0][m][0] * v0, acc[ai][0][m][1] * v1); }
        } else {
            const int col = (pn - 28) * 128 + cl;
            const f32x4 ba0 = *(const f32x4*)(b_gate + col), ba1 = *(const f32x4*)(b_gate + col + 4), bc0 = *(const f32x4*)(b_gate + 1024 + col), bc1 = *(const f32x4*)(b_gate + 1024 + col + 4);
#pragma unroll
            for (int ai = 0; ai < 2; ++ai)
#pragma unroll
                for (int m = 0; m < 4; ++m) { const size_t off = (size_t)(row0 + ai * HALF + m * 16) * 1024 + col;
                    f32x4 a0 = acc[ai][0][m][0] + ba0, a1 = acc[ai][0][m][1] + ba1, c0 = acc[ai][1][m][0] + bc0, c1 = acc[ai][1][m][1] + bc1;
                    {
                        const f32x4 lo = (f32x4){-30.f, -30.f, -30.f, -30.f};
                        const f32x4 dc0 = exp2n4(__builtin_elementwise_max(c0, lo)) + 1.f, dc1 = exp2n4(__builtin_elementwise_max(c1, lo)) + 1.f;
                        const f32x4 ra0 = rcp4(exp2n4(a0) + 1.f), ra1 = rcp4(exp2n4(a1) + 1.f);
                        a0 = dc0 * ra0; a1 = dc1 * ra1; c0 = rcp4(dc0); c1 = rcp4(dc1); }
                    *(u32x4*)(GR + off) = pack8(a0, a1); *(u32x4*)(GC + off) = pack8(c0, c1); }
        }
    }
};

struct EpiMerge {
    static constexpr bool PERM = true, AFTER_DRAIN = false;
    const bf16_t *GR, *GC; bf16_t* MG; int nM, nN;
    __device__ __forceinline__ void acc_init(f32x4 (&acc)[2][2][4][2], const Unit&, int, int, int, int) const {
#pragma unroll
        for (int a = 0; a < 2; ++a)
#pragma unroll
            for (int b = 0; b < 2; ++b)
#pragma unroll
                for (int m = 0; m < 4; ++m)
#pragma unroll
                    for (int n = 0; n < 2; ++n) acc[a][b][m][n] = (f32x4){0.f, 0.f, 0.f, 0.f};
    }
    __device__ __forceinline__ bool keep(const Unit& u) const { return u.pm < nM; }
    __device__ __forceinline__ void operator()(f32x4 (&acc)[2][2][4][2], const Unit& u, int wr, int wc, int fr, int fq) const {
        const bool h0 = u.pm < nM; const int pm = h0 ? u.pm : u.pm - nM, pn = h0 ? u.pn : u.pn - nN;
        const int row0 = pm * BM + wr * 64 + fr, col0 = pn * BM + wc * 32 + 8 * fq;
        const bf16_t* G = h0 ? GR : GC;
        const __amdgpu_buffer_rsrc_t mg_r = __builtin_amdgcn_make_buffer_rsrc((void*)MG, 0, 16384 * 1024 * 2, 0x00020000);
#pragma unroll
        for (int ai = 0; ai < 2; ++ai)
#pragma unroll
            for (int m = 0; m < 4; ++m) { const size_t off = (size_t)(row0 + ai * HALF + m * 16) * 1024 + col0;
#pragma unroll
                for (int bj = 0; bj < 2; ++bj) { const u32x4 w = __builtin_nontemporal_load((const u32x4*)(G + off + bj * HALF)); f32x4 g0, g1; unpack8(w, g0, g1);
                    acc[ai][bj][m][0] *= g0; acc[ai][bj][m][1] *= g1;
                    if (!h0) st16_wt(mg_r, (unsigned)((off + bj * HALF) * 2), pack8(acc[ai][bj][m][0], acc[ai][bj][m][1])); } }
    }
};

template <bool DRAIN = true, bool ACQ = true> __device__ __forceinline__ void panel_barrier(unsigned* cnt, unsigned want) {
    if (DRAIN) asm volatile("s_waitcnt vmcnt(0)" ::: "memory");
    __syncthreads();
    if (threadIdx.x == 0) {
        __hip_atomic_fetch_add(cnt, 1u, __ATOMIC_RELAXED, __HIP_MEMORY_SCOPE_AGENT);
        unsigned sp = 0u;
        while (__hip_atomic_load(cnt, __ATOMIC_RELAXED, __HIP_MEMORY_SCOPE_AGENT) < want) { __builtin_amdgcn_s_sleep(1); if (++sp > (1u << 22)) break; }
        if (ACQ) { __builtin_amdgcn_fence(__ATOMIC_ACQUIRE, "agent"); asm volatile("s_waitcnt vmcnt(0)" ::: "memory"); }
    }
    __syncthreads();
}
struct EpiOutNorm {
    static constexpr bool PERM = false, AFTER_DRAIN = true;
    const float* x; float* out; const float* fg; float* XB; unsigned* cnt;
    __device__ __forceinline__ bool keep(const Unit&) const { return false; }
    __device__ __forceinline__ void acc_init(f32x4 (&acc)[2][2][4][2], const Unit& u, int wr, int wc, int fr, int fq) const {
        const int col0 = u.pn * BM + wc * 32 + 4 * fq;
        asm volatile("s_waitcnt vmcnt(0)" ::: "memory");
#pragma unroll
        for (int ai = 0; ai < 2; ++ai)
#pragma unroll
            for (int m = 0; m < 4; ++m) { const size_t offe = (size_t)(u.pm * BM + ai * HALF + wr * 64 + m * 16 + (fr & ~1)) * 1024 + col0;
#pragma unroll
                for (int bj = 0; bj < 2; ++bj) load_lines_f32_nt(x + offe + bj * HALF, 1024, fr & 1, acc[ai][bj][m][0], acc[ai][bj][m][1]); }
    }
    __device__ __forceinline__ void fused(f32x4 (&acc)[2][2][4][2], const Unit& u, int wr, int wc, int fr, int fq, PG8_LAS unsigned char* lds, int wid, int lane) const {
        PG8_LAS float* P = (PG8_LAS float*)lds;
        PG8_LAS float* Sr = (PG8_LAS float*)(lds + 4096);
        const int col0 = u.pn * BM + wc * 32 + 4 * fq;
#pragma unroll
        for (int ai = 0; ai < 2; ++ai)
#pragma unroll
            for (int m = 0; m < 4; ++m) { const int rl = ai * HALF + wr * 64 + m * 16 + fr; float ss = 0.f;
#pragma unroll
                for (int bj = 0; bj < 2; ++bj)
#pragma unroll
                    for (int n = 0; n < 2; ++n) { const f32x4 o = acc[ai][bj][m][n]; ss += (o[0] * o[0] + o[1] * o[1]) + (o[2] * o[2] + o[3] * o[3]); }
                ss += __shfl_xor(ss, 16); ss += __shfl_xor(ss, 32);
                if (fq == 0) P[rl * 4 + wc] = ss; }
        asm volatile("s_waitcnt lgkmcnt(0)" ::: "memory"); __builtin_amdgcn_s_barrier(); asm volatile("" ::: "memory");
        const int tid = wid * 64 + lane;
        float* xb = XB + ((size_t)u.pm * 256 + (tid & 255)) * 4;
        if (tid < 256) { const f32x4 pv = *(const PG8_LAS f32x4*)(P + tid * 4); __hip_atomic_store(xb + u.pn, (pv[0] + pv[1]) + (pv[2] + pv[3]), __ATOMIC_RELAXED, __HIP_MEMORY_SCOPE_AGENT); }
        panel_barrier<true, false>(cnt + (size_t)u.pm * 3 * 64, 4u);
        if (tid < 256) { float tv[4];
#pragma unroll
            for (int k = 0; k < 4; ++k) tv[k] = __hip_atomic_load(xb + k, __ATOMIC_RELAXED, __HIP_MEMORY_SCOPE_AGENT);
            const float tot = (tv[0] + tv[1]) + (tv[2] + tv[3]); Sr[tid] = 1.f / sqrtf(tot * (1.f / 1024.f) + 1e-6f); }
        asm volatile("s_waitcnt lgkmcnt(0)" ::: "memory"); __builtin_amdgcn_s_barrier(); asm volatile("" ::: "memory");
        f32x4 gv[2][2];
#pragma unroll
        for (int bj = 0; bj < 2; ++bj)
#pragma unroll
            for (int n = 0; n < 2; ++n) gv[bj][n] = *(const f32x4*)(fg + col0 + bj * HALF + n * 16);
#pragma unroll
        for (int ai = 0; ai < 2; ++ai)
#pragma unroll
            for (int m = 0; m < 4; ++m) { const int rl = ai * HALF + wr * 64 + m * 16 + fr; const size_t offe = (size_t)(u.pm * BM + (rl & ~1)) * 1024 + col0; const float rs = Sr[rl];
#pragma unroll
                for (int bj = 0; bj < 2; ++bj) store_lines_f32_nt(out + offe + bj * HALF, 1024, fr & 1, acc[ai][bj][m][0] * rs * gv[bj][0], acc[ai][bj][m][1] * rs * gv[bj][1]); }
    }
};

template <class Epi, class Sched, bool ALIGN_EPI = false, bool SP2 = false>
__device__ __forceinline__ void gemm_phase(PG8_LAS unsigned char* lds, const Gemm g, const Sched& S, const Epi& E) {
    int tid_ = threadIdx.x; asm volatile("" : "+v"(tid_));
    const int tid = tid_, wid = __builtin_amdgcn_readfirstlane(tid >> 6), lane = tid & 63, wr = wid >> 2, wc = wid & 3, fr = lane & 15, fq = lane >> 4;
    const int K = g.K, nt = K / BK;
    unsigned voffA[2], voffB[2];
#pragma unroll
    for (int i = 0; i < 2; ++i) { int R, C; stage_rc(tid * 16 + i * 8192, R, C); const int Rb = Epi::PERM ? ((R & ~31) + perm32(R & 31)) : R;
        voffA[i] = (unsigned)(R * K + C) * 2u; voffB[i] = (unsigned)(Rb * K + C) * 2u; }
    const size_t kstep = (size_t)(BK * 2);
    const size_t hstep = (size_t)HALF * K * 2;
    const size_t tstep = 2 * hstep;
    const unsigned ldsw = (unsigned)wid * 1024u;
    const int aoff = lds_byte(wr * 64 + fr, fq * 8), boff = lds_byte(wc * 32 + fr, fq * 8);
#define PG8_SA(b, h) (((b) * 2 + (h)) * HTB)
#define PG8_SB(b, h) ((4 + (b) * 2 + (h)) * HTB)
#define PG8_STAGE(bufoff, gbase, voff) do { _Pragma("unroll") for (int _i = 0; _i < 2; ++_i) \
        __builtin_amdgcn_global_load_lds((const unsigned*)((const char*)(gbase) + (voff)[_i]), (PG8_LAS unsigned*)(lds + (bufoff) + ldsw + _i * 8192), 16, 0, 0); } while (0)
#define PG8_LDA(dst, b, h) do { _Pragma("unroll") for (int m = 0; m < 4; ++m) _Pragma("unroll") for (int k = 0; k < 2; ++k) dst[m][k] = *(const PG8_LAS bf16x8*)(lds + PG8_SA(b, h) + aoff + m * 2048 + k * 1024); } while (0)
#define PG8_LDB(dst, b, h) do { _Pragma("unroll") for (int n = 0; n < 2; ++n) _Pragma("unroll") for (int k = 0; k < 2; ++k) dst[n][k] = *(const PG8_LAS bf16x8*)(lds + PG8_SB(b, h) + boff + n * 2048 + k * 1024); } while (0)
#define PG8_MMA(ai, bj, At, Bt) do { __builtin_amdgcn_s_setprio(1); _Pragma("unroll") for (int m = 0; m < 4; ++m) _Pragma("unroll") for (int n = 0; n < 2; ++n) _Pragma("unroll") for (int k = 0; k < 2; ++k) \
        acc[ai][bj][m][n] = __builtin_amdgcn_mfma_f32_16x16x32_bf16(Bt[n][k], At[m][k], acc[ai][bj][m][n], 0, 0, 0); __builtin_amdgcn_s_setprio(0); } while (0)
#define PG8_WAIT_V(n) asm volatile("s_waitcnt vmcnt(" #n ")" ::: "memory")
#define PG8_WAIT_L(n) asm volatile("s_waitcnt lgkmcnt(" #n ")" ::: "memory")
#define PG8_BAR __builtin_amdgcn_s_barrier()
#define PG8_SCHED __builtin_amdgcn_sched_barrier(0)
    Unit cur, nxt; int ui = 0;
    if (!S.next(0, cur)) return;
    f32x4 acc[2][2][4][2];
    E.acc_init(acc, cur, wr, wc, fr, fq);
    bf16x8 At[4][2], B0[2][2], B1[2][2];
    const char* cA = (const char*)g.A + (size_t)cur.pm * tstep; const char* cB = (const char*)g.Bt + (size_t)cur.pn * tstep;
    if constexpr (!SP2) S.a_ready(cur);
    if constexpr (SP2) {
        PG8_STAGE(PG8_SB(0, 0), cB, voffB); PG8_STAGE(PG8_SB(0, 1), cB + hstep, voffB); S.a_ready(cur);
        PG8_STAGE(PG8_SA(0, 0), cA, voffA); PG8_STAGE(PG8_SA(0, 1), cA + hstep, voffA);
        if (wr == 1) PG8_BAR;
        PG8_WAIT_V(2); PG8_BAR;
        PG8_STAGE(PG8_SB(1, 0), cB + kstep, voffB); PG8_STAGE(PG8_SA(1, 0), cA + kstep, voffA); PG8_STAGE(PG8_SB(1, 1), cB + hstep + kstep, voffB);
        PG8_WAIT_V(6); PG8_BAR;
    } else {
        PG8_STAGE(PG8_SB(0, 0), cB, voffB); PG8_STAGE(PG8_SA(0, 0), cA, voffA); PG8_STAGE(PG8_SB(0, 1), cB + hstep, voffB); PG8_STAGE(PG8_SA(0, 1), cA + hstep, voffA);
        if (wr == 1) PG8_BAR;
        PG8_WAIT_V(4); PG8_BAR;
        PG8_STAGE(PG8_SB(1, 0), cB + kstep, voffB); PG8_STAGE(PG8_SA(1, 0), cA + kstep, voffA); PG8_STAGE(PG8_SB(1, 1), cB + hstep + kstep, voffB);
        PG8_WAIT_V(6); PG8_BAR;
    }
    for (;;) {
        const bool has_next = S.next(ui + 1, nxt);
        const char* nA = has_next ? (const char*)g.A + (size_t)nxt.pm * tstep : cA; const char* nB = has_next ? (const char*)g.Bt + (size_t)nxt.pn * tstep : cB;
        for (int t = 0; t < nt; t += 2) {
            const bool last = (t == nt - 2);
            const char* a1 = cA + (size_t)(t + 1) * kstep;
            const char* a2 = last ? nA : cA + (size_t)(t + 2) * kstep; const char* b2 = last ? nB : cB + (size_t)(t + 2) * kstep;
            const char* a3 = a2 + kstep; const char* b3 = b2 + kstep;
            if (last && has_next) S.a_ready(nxt);
            if constexpr (SP2) {
            PG8_LDB(B0, 0, 0); PG8_LDB(B1, 0, 1); PG8_SCHED; PG8_LDA(At, 0, 0); PG8_STAGE(PG8_SA(1, 1), a1 + hstep, voffA);
            PG8_WAIT_V(8); PG8_WAIT_L(0); PG8_BAR; PG8_MMA(0, 0, At, B0); PG8_MMA(0, 1, At, B1); PG8_BAR; PG8_SCHED;
            PG8_LDA(At, 0, 1); PG8_STAGE(PG8_SB(0, 0), b2, voffB); PG8_STAGE(PG8_SB(0, 1), b2 + hstep, voffB); PG8_STAGE(PG8_SA(0, 0), a2, voffA);
            PG8_WAIT_V(8); PG8_WAIT_L(0); PG8_BAR; PG8_MMA(1, 0, At, B0); PG8_MMA(1, 1, At, B1); PG8_BAR; PG8_SCHED;
            PG8_LDB(B0, 1, 0); PG8_LDB(B1, 1, 1); PG8_SCHED; PG8_LDA(At, 1, 0); PG8_STAGE(PG8_SA(0, 1), a2 + hstep, voffA);
            PG8_WAIT_V(8); PG8_WAIT_L(0); PG8_BAR; PG8_MMA(0, 0, At, B0); PG8_MMA(0, 1, At, B1); PG8_BAR; PG8_SCHED;
            PG8_LDA(At, 1, 1); PG8_STAGE(PG8_SB(1, 0), b3, voffB); PG8_STAGE(PG8_SB(1, 1), b3 + hstep, voffB); PG8_STAGE(PG8_SA(1, 0), a3, voffA);
            PG8_WAIT_V(8); PG8_WAIT_L(0); PG8_BAR; PG8_MMA(1, 0, At, B0); PG8_MMA(1, 1, At, B1); PG8_BAR; PG8_SCHED;
            } else {
            PG8_LDB(B0, 0, 0); PG8_SCHED; PG8_LDA(At, 0, 0); PG8_STAGE(PG8_SA(1, 1), a1 + hstep, voffA);
            PG8_WAIT_L(8); PG8_BAR; PG8_WAIT_L(0); PG8_MMA(0, 0, At, B0); PG8_BAR; PG8_SCHED;
            PG8_LDB(B1, 0, 1); PG8_STAGE(PG8_SB(0, 0), b2, voffB);
            PG8_BAR; PG8_WAIT_L(0); PG8_MMA(0, 1, At, B1); PG8_BAR;
            PG8_LDA(At, 0, 1); PG8_STAGE(PG8_SA(0, 0), a2, voffA);
            PG8_BAR; PG8_WAIT_L(0); PG8_MMA(1, 0, At, B0); PG8_BAR; PG8_SCHED;
            PG8_STAGE(PG8_SB(0, 1), b2 + hstep, voffB);
            PG8_WAIT_V(6); PG8_BAR; PG8_MMA(1, 1, At, B1); PG8_BAR;
            PG8_LDB(B0, 1, 0); PG8_SCHED; PG8_LDA(At, 1, 0); PG8_STAGE(PG8_SA(0, 1), a2 + hstep, voffA);
            PG8_WAIT_L(8); PG8_BAR; PG8_WAIT_L(0); PG8_MMA(0, 0, At, B0); PG8_BAR; PG8_SCHED;
            PG8_LDB(B1, 1, 1); PG8_STAGE(PG8_SB(1, 0), b3, voffB);
            PG8_BAR; PG8_WAIT_L(0); PG8_MMA(0, 1, At, B1); PG8_BAR;
            PG8_LDA(At, 1, 1); PG8_STAGE(PG8_SA(1, 0), a3, voffA);
            PG8_BAR; PG8_WAIT_L(0); PG8_MMA(1, 0, At, B0); PG8_BAR; PG8_SCHED;
            PG8_STAGE(PG8_SB(1, 1), b3 + hstep, voffB);
            PG8_WAIT_V(6); PG8_BAR; PG8_MMA(1, 1, At, B1); PG8_BAR;
            }
        }
        if constexpr (ALIGN_EPI) { if (wr == 0) PG8_BAR; }
        if constexpr (!Epi::AFTER_DRAIN) { E(acc, cur, wr, wc, fr, fq); S.done(cur); }
        if (!has_next) break;
        if (!E.keep(cur)) {
#pragma unroll
        for (int a = 0; a < 2; ++a)
#pragma unroll
            for (int b = 0; b < 2; ++b)
#pragma unroll
                for (int m = 0; m < 4; ++m)
#pragma unroll
                    for (int n = 0; n < 2; ++n) acc[a][b][m][n] = (f32x4){0.f, 0.f, 0.f, 0.f};
        }
        cur = nxt; cA = nA; cB = nB; ++ui;
        if constexpr (ALIGN_EPI) { if (wr == 1) PG8_BAR; }
    }
    PG8_WAIT_V(0);
    if constexpr (!ALIGN_EPI) { if (wr == 0) PG8_BAR; }
    PG8_BAR;
    if constexpr (Epi::AFTER_DRAIN) { E.fused(acc, cur, wr, wc, fr, fq, lds, wid, lane); S.done(cur); }
#undef PG8_SA
#undef PG8_SB
#undef PG8_STAGE
#undef PG8_LDA
#undef PG8_LDB
#undef PG8_MMA
#undef PG8_WAIT_V
#undef PG8_WAIT_L
#undef PG8_BAR
#undef PG8_SCHED
}
}

#define LAS __attribute__((address_space(3)))
typedef unsigned short bf16;
typedef unsigned u32x4 __attribute__((ext_vector_type(4)));
typedef unsigned u32x2 __attribute__((ext_vector_type(2)));
typedef float f32x4 __attribute__((ext_vector_type(4)));
typedef float f32x16 __attribute__((ext_vector_type(16)));
typedef short bf16x8 __attribute__((ext_vector_type(8)));

constexpr int DM = 1024, NTOK = 32768, CH = 16384, NCHUNK = 2, INW = 9216, QP = 4608;
constexpr float RMS_EPS = 1e-6f;
constexpr size_t MiB = 1u << 20;
constexpr size_t WS_WIN = 0, WS_WAC = 18 * MiB, WS_WO = 20 * MiB, WS_SS = 22 * MiB, WS_LSE = 23 * MiB, WS_XN = 32 * MiB, WS_QKV = 96 * MiB,
                 WS_ZA = 240 * MiB, WS_U = 256 * MiB, WS_T = 272 * MiB, WS_GR = 288 * MiB, WS_GC = 320 * MiB, WS_A12 = 352 * MiB, WS_MG = 384 * MiB, WS_OB = 416 * MiB  , WS_ZA2 = 464 * MiB  , WS_END = 480 * MiB;
constexpr size_t WS_XB = WS_SS;
constexpr size_t WS_BAR = WS_SS + 768 * 1024;
constexpr int CTL_WORDS = 32768, PANEL_CNT0 = 4096;
constexpr int NWAVES = 8, NTHREADS = 512;
constexpr int LDS_BYTES = 147456, BST_OFF = 146432;

__device__ __forceinline__ unsigned f2bf(float f) { unsigned u = __builtin_bit_cast(unsigned, f); return (u + 0x7fffu + ((u >> 16) & 1u)) >> 16; }
__device__ __forceinline__ unsigned pk2(float lo, float hi) { return f2bf(lo) | (f2bf(hi) << 16); }
__device__ __forceinline__ float wave_sum(float v) {
#pragma unroll
    for (int o = 1; o < 64; o <<= 1) v += __shfl_xor(v, o);
    return v;
}

__device__ __forceinline__ int win_dest(int e) {
    if (e < 5120) { const int Lb = e & 255; return (e & ~255) + 128 * ((Lb >> 5) & 1) + 32 * (Lb >> 6) + (Lb & 31); }
    if (e < 7168) { const int i = (e - 5120) & 511, kind = (e - 5120) >> 9;
        const int j = i >> 7, c = i & 127; const int tile = ((kind & 1) ? 24 : 20) + j; return tile * 256 + ((kind >> 1) ? 128 : 0) + c; }
    { const int i = (e - 7168) & 1023, isc = (e - 7168) >> 10; const int j = i >> 7, c = i & 127; return (28 + j) * 256 + (isc ? 128 : 0) + c; }
}
__device__ __forceinline__ void p0_transpose_item(const float* W, int K, int N, bf16* WT, int dest_row0, int k0, int n0, LAS float* scr, int lane) {
#pragma unroll 8
    for (int i = 0; i < 32; ++i) { const int kk = 2 * i + (lane >> 5); scr[kk * 33 + (lane & 31)] = __builtin_nontemporal_load(W + (size_t)(k0 + kk) * N + n0 + (lane & 31)); }
    asm volatile("s_waitcnt lgkmcnt(0)" ::: "memory");
    const int c = lane & 7;
#pragma unroll
    for (int j = 0; j < 4; ++j) { const int n = (lane >> 3) + 8 * j; const LAS float* s = scr + (8 * c) * 33 + n;
        u32x4 o; o.x = pk2(s[0 * 33], s[1 * 33]); o.y = pk2(s[2 * 33], s[3 * 33]); o.z = pk2(s[4 * 33], s[5 * 33]); o.w = pk2(s[6 * 33], s[7 * 33]);
        *(u32x4*)(WT + (size_t)(dest_row0 + n) * K + k0 + 8 * c) = o; }
    asm volatile("s_waitcnt lgkmcnt(0)" ::: "memory");
}

struct Params {
    const float *x_prompt, *x_sample, *norm_g, *w_in, *b_gate, *conv_w, *w_attn_out, *w_conv_out, *w_o, *final_g;
    float* out; unsigned char* ws;
    int use_cg_sync, pad;
};

__device__ __forceinline__ const float* xrow_ptr(const Params& p, int row) { return row < CH ? p.x_prompt + (size_t)row * DM : p.x_sample + (size_t)(row - CH) * DM; }

__device__ __forceinline__ void phase_prologue(const Params& p, LAS unsigned char* lds, int gw, int NGW, int wave, int lane) {
    LAS float* scr = (LAS float*)(lds + wave * 16384);
    bf16* WIN = (bf16*)(p.ws + WS_WIN); bf16* WAC = (bf16*)(p.ws + WS_WAC); bf16* WO = (bf16*)(p.ws + WS_WO);
    constexpr int I_IN = (DM / 64) * (INW / 32), I_A = (512 / 64) * (DM / 32), I_O = (DM / 64) * (DM / 32);
    constexpr int NITEMS = I_IN + 2 * I_A + I_O;
    for (int it = gw; it < NITEMS; it += NGW) {
        int r = it;
        if (r < I_IN) { const int nblk = INW / 32, kb = r / nblk, nb = r % nblk; p0_transpose_item(p.w_in, DM, INW, WIN, win_dest(32 * nb), 64 * kb, 32 * nb, scr, lane); continue; } r -= I_IN;
        if (r < I_A) { const int nblk = DM / 32, kb = r / nblk, nb = r % nblk; p0_transpose_item(p.w_attn_out, 512, DM, WAC, 32 * nb, 64 * kb, 32 * nb, scr, lane); continue; } r -= I_A;
        if (r < I_A) { const int nblk = DM / 32, kb = r / nblk, nb = r % nblk; p0_transpose_item(p.w_conv_out, 512, DM, WAC, 1024 + 32 * nb, 64 * kb, 32 * nb, scr, lane); continue; } r -= I_A;
        { const int nblk = DM / 32, kb = r / nblk, nb = r % nblk; p0_transpose_item(p.w_o, DM, DM, WO, 32 * nb, 64 * kb, 32 * nb, scr, lane); }
    }
    bf16* XN = (bf16*)(p.ws + WS_XN);
    f32x4 gv[4];
#pragma unroll
    for (int j = 0; j < 4; ++j) gv[j] = *((const f32x4*)p.norm_g + lane + 64 * j);
    for (int m = gw; m < NTOK; m += NGW) {
        const f32x4* xr = (const f32x4*)xrow_ptr(p, m) + lane;
        f32x4 v[4]; float s = 0.f;
#pragma unroll
        for (int j = 0; j < 4; ++j) { v[j] = __builtin_nontemporal_load(xr + 64 * j); s += (v[j].x * v[j].x + v[j].y * v[j].y) + (v[j].z * v[j].z + v[j].w * v[j].w); }
        const float rstd = 1.f / sqrtf(wave_sum(s) * (1.f / DM) + RMS_EPS);
        unsigned long long* o8 = (unsigned long long*)(XN + (size_t)m * DM) + lane;
#pragma unroll
        for (int j = 0; j < 4; ++j) { const f32x4 y = v[j] * rstd * gv[j]; o8[64 * j] = (unsigned long long)pk2(y.x, y.y) | ((unsigned long long)pk2(y.z, y.w) << 32); }
    }
}

constexpr int KP = 144, VP = 776, K_OFF = 0, V_OFF = 384 * KP, Q_OFF = V_OFF + 64 * VP, ATT_LDS = Q_OFF + 256 * KP;
static_assert(ATT_LDS <= BST_OFF, "attention LDS");
__device__ __forceinline__ int crow(int r, int hi) { return (r & 3) + 8 * (r >> 2) + 4 * hi; }

struct AttnDesc { int R0, L, dsh, g, h, res, q0; };
__device__ __forceinline__ AttnDesc attn_decode(int u, int S) {
    AttnDesc d; const int bps = S / 256; const int gh = u >> 6, blk = u & 63; d.g = gh >> 3; d.h = gh & 7;
    const int seq = blk / bps, bl = blk % bps; d.R0 = seq * S; d.dsh = 2 * d.g; d.L = S >> d.dsh;
    const int Lb = d.L / 256; d.res = bl / Lb; d.q0 = (bl % Lb) * 256; return d;
}
__device__ __forceinline__ void attn_load(const AttnDesc& d, const bf16* QKV, int tid, u32x4 (&kr)[6], u32x4 (&va)[3], u32x4 (&vb)[3], u32x4 (&qc)[4]) {
    const int lane = tid & 63, wid = tid >> 6, ql = lane & 31, hi = lane >> 5, dil = 1 << d.dsh;
    const bf16* Kg = QKV + 1536 + d.g * 512 + d.h * 64; const bf16* Vg = Kg + 1536;
#pragma unroll
    for (int j = 0; j < 4; ++j) { const int c = tid + 512 * j, i = c >> 3, ch = c & 7;
        qc[j] = *(const u32x4*)(QKV + (size_t)(d.R0 + (d.q0 + i) * dil + d.res) * QP + d.g * 512 + d.h * 64 + ch * 8); }
#pragma unroll
    for (int j = 0; j < 6; ++j) { const int c = tid + 512 * j, i = c >> 3, ch = c & 7, pos = d.q0 - 64 + i;
        const int pc = min(max(pos, 0), d.L - 1);
        kr[j] = *(const u32x4*)(Kg + (size_t)(d.R0 + pc * dil + d.res) * QP + ch * 8); }
#pragma unroll
    for (int j = 0; j < 3; ++j) { const int c = tid + 512 * j, kp = c >> 3, ch = c & 7, pos = d.q0 - 64 + 2 * kp;
        const int pc = min(max(pos, 0), d.L - 2);
        const bf16* src = Vg + (size_t)(d.R0 + pc * dil + d.res) * QP + ch * 8; va[j] = *(const u32x4*)src; vb[j] = *(const u32x4*)(src + (size_t)dil * QP); }
}
__device__ __forceinline__ void attn_stage(LAS unsigned char* lds, int tid, const u32x4 (&kr)[6], const u32x4 (&va)[3], const u32x4 (&vb)[3], const u32x4 (&qc)[4]) {
#pragma unroll
    for (int j = 0; j < 4; ++j) { const int c = tid + 512 * j, i = c >> 3, ch = c & 7; *(LAS u32x4*)(lds + Q_OFF + i * KP + ch * 16) = qc[j]; }
#pragma unroll
    for (int j = 0; j < 6; ++j) { const int c = tid + 512 * j, i = c >> 3, ch = c & 7; *(LAS u32x4*)(lds + K_OFF + i * KP + ch * 16) = kr[j]; }
#pragma unroll
    for (int j = 0; j < 3; ++j) { const int c = tid + 512 * j, kp = c >> 3, ch = c & 7;
        LAS unsigned char* dst = lds + V_OFF + (ch * 8) * VP + kp * 4;
#pragma unroll
        for (int e = 0; e < 4; ++e) { const unsigned wa = va[j][e], wb = vb[j][e];
            *(LAS unsigned*)(dst + (2 * e) * VP) = (wa & 0xffffu) | (wb << 16);
            *(LAS unsigned*)(dst + (2 * e + 1) * VP) = (wa >> 16) | (wb & 0xffff0000u); } }
}
__device__ __forceinline__ void attn_compute(LAS unsigned char* lds, const AttnDesc& d, bf16* OB, float* LSE, int tid_in) {
    int tid = tid_in; asm volatile("" : "+v"(tid));
    const int lane = tid & 63, wid = tid >> 6, ql = lane & 31, hi = lane >> 5, dil = 1 << d.dsh;
    const int qpos = d.q0 + 32 * wid + ql;
    const size_t qrow = (size_t)(d.R0 + qpos * dil + d.res);
    LAS unsigned char* qimg = lds + Q_OFF + (32 * wid) * KP;
    bf16x8 qr[4];
#pragma unroll
    for (int d0 = 0; d0 < 4; ++d0) qr[d0] = *(const LAS bf16x8*)(qimg + ql * KP + d0 * 32 + hi * 16);
    const float slope = exp2f(-(float)(d.g * 8 + d.h + 1) * (1.0f / 3.0f));
    const float sl2 = slope * (float)dil * 1.4426950408889634f;
    float lanef = (float)(4 * hi - ql); asm volatile("" : "+v"(lanef));
    const float qposf = (float)qpos;
    const float lo = fmaxf(-64.f, -qposf), hi_ = fminf(64.f, (float)(d.L - 1) - qposf);
    const bool edge = (d.q0 == 0) || (d.q0 + 256 >= d.L);
    typedef float f32x2 __attribute__((ext_vector_type(2)));
    const f32x2 lane2 = (f32x2){lanef, lanef};
    float mx = -3.0e38f, lsum = 0.f;
    f32x16 o[2]; o[0] = f32x16{}; o[1] = f32x16{};
#pragma unroll
    for (int bi = 0; bi < 5; ++bi) {
        const int b = bi == 0 ? 2 : bi == 1 ? 1 : bi == 2 ? 3 : bi == 3 ? 0 : 4;
        const LAS unsigned char* kb = lds + K_OFF + (32 * wid + 32 * b + ql) * KP + hi * 16;
        f32x16 a = {};
#pragma unroll
        for (int d0 = 0; d0 < 4; ++d0) { const bf16x8 kf = *(const LAS bf16x8*)(kb + d0 * 32); a = __builtin_amdgcn_mfma_f32_32x32x16_bf16(kf, qr[d0], a, 0, 0, 0); }
        f32x2 t2[8];
#pragma unroll
        for (int r = 0; r < 16; r += 2) { const float c0 = (float)(-64 + 32 * b + (r & 3) + 8 * (r >> 2));
            t2[r >> 1] = (f32x2){c0, c0 + 1.f} + lane2;
            f32x2 v = (f32x2){a[r], a[r + 1]};
            if (b < 2) v = v + t2[r >> 1] * sl2; else if (b > 2) v = v - t2[r >> 1] * sl2;
            else { v.x -= sl2 * __builtin_fabsf(t2[r >> 1].x); v.y -= sl2 * __builtin_fabsf(t2[r >> 1].y); }
            a[r] = v.x; a[r + 1] = v.y; }
        if (b == 0 || (edge && b <= 2)) {
#pragma unroll
            for (int r = 0; r < 16; ++r) { const float t = (r & 1) ? t2[r >> 1].y : t2[r >> 1].x; a[r] = (t >= lo) ? a[r] : -1.0e30f; } }
        if (b == 4 || (edge && b >= 2)) {
#pragma unroll
            for (int r = 0; r < 16; ++r) { const float t = (r & 1) ? t2[r >> 1].y : t2[r >> 1].x; a[r] = (t <= hi_) ? a[r] : -1.0e30f; } }
        float bm = fmaxf(fmaxf(a[0], a[1]), a[2]);
#pragma unroll
        for (int r = 3; r < 15; r += 2) bm = fmaxf(fmaxf(bm, a[r]), a[r + 1]);
        bm = fmaxf(bm, a[15]);
        bm = fmaxf(bm, __shfl_xor(bm, 32));
        const float mn = fmaxf(mx, bm);
        if (bi > 0 && __any(mn > mx)) { const float alpha = __builtin_amdgcn_exp2f(mx - mn); lsum *= alpha;
#pragma unroll
            for (int r = 0; r < 16; ++r) { o[0][r] *= alpha; o[1][r] *= alpha; } }
        mx = mn;
        const f32x2 m2 = (f32x2){mx, mx};
        f32x2 ls2 = (f32x2){0.f, 0.f};
#pragma unroll
        for (int r = 0; r < 16; r += 2) { const f32x2 dlt = (f32x2){a[r], a[r + 1]} - m2; f32x2 e; e.x = __builtin_amdgcn_exp2f(dlt.x); e.y = __builtin_amdgcn_exp2f(dlt.y); a[r] = e.x; a[r + 1] = e.y; ls2 = ls2 + e; }
        lsum += ls2.x + ls2.y;
#pragma unroll
        for (int j = 0; j < 2; ++j) {
            u32x4 pw; pw.x = pg8::cvt_pk_bf16(a[8 * j + 0], a[8 * j + 1]); pw.y = pg8::cvt_pk_bf16(a[8 * j + 2], a[8 * j + 3]);
            pw.z = pg8::cvt_pk_bf16(a[8 * j + 4], a[8 * j + 5]); pw.w = pg8::cvt_pk_bf16(a[8 * j + 6], a[8 * j + 7]);
            const bf16x8 pa = __builtin_bit_cast(bf16x8, pw);
#pragma unroll
            for (int d0 = 0; d0 < 2; ++d0) {
                const LAS unsigned char* vp = lds + V_OFF + (d0 * 32 + ql) * VP + (32 * wid + 32 * b + 16 * j + 4 * hi) * 2;
                const u32x2 v0 = *(const LAS u32x2*)vp, v1 = *(const LAS u32x2*)(vp + 16);
                const u32x4 vw = (u32x4){v0.x, v0.y, v1.x, v1.y};
                o[d0] = __builtin_amdgcn_mfma_f32_32x32x16_bf16(__builtin_bit_cast(bf16x8, vw), pa, o[d0], 0, 0, 0);
            }
        }
    }
    lsum += __shfl_xor(lsum, 32);
    const float inv = 1.f / lsum;
#pragma unroll
    for (int d0 = 0; d0 < 2; ++d0)
#pragma unroll
        for (int k = 0; k < 4; ++k) { u32x2 w; w.x = pg8::cvt_pk_bf16(o[d0][4 * k] * inv, o[d0][4 * k + 1] * inv); w.y = pg8::cvt_pk_bf16(o[d0][4 * k + 2] * inv, o[d0][4 * k + 3] * inv);
            *(LAS u32x2*)(qimg + ql * KP + (d0 * 32 + 8 * k + 4 * hi) * 2) = w; }
    asm volatile("s_waitcnt lgkmcnt(0)" ::: "memory");
#pragma unroll
    for (int j = 0; j < 4; ++j) { const int idx = lane + 64 * j, r = idx >> 3, ch = idx & 7;
        const u32x4 v = *(const LAS u32x4*)(qimg + r * KP + ch * 16);
        *(u32x4*)(OB + (size_t)(d.R0 + (d.q0 + 32 * wid + r) * dil + d.res) * 1536 + d.g * 512 + d.h * 64 + ch * 8) = v; }
    if (hi == 0) LSE[qrow * 24 + d.g * 8 + d.h] = mx + log2f(lsum);
}

__device__ __forceinline__ void phase_attention(const Params& p, LAS unsigned char* lds, int chunk, int G, int tid_in) {
    int tid = tid_in; asm volatile("" : "+v"(tid));
    const bf16* QKV = (const bf16*)(p.ws + WS_QKV); bf16* OB = (bf16*)(p.ws + WS_OB); float* LSE = (float*)(p.ws + WS_LSE);
    const int S = chunk == 0 ? 16384 : 8192;
    constexpr int NU = 24 * 64;
    int u = (G % 8 == 0) ? ((int)blockIdx.x % 8) * (G / 8) + (int)blockIdx.x / 8 : (int)blockIdx.x;
    if (u >= NU) return;
    u32x4 kr[6], va[3], vb[3], qn[4];
    AttnDesc d = attn_decode(u, S);
    attn_load(d, QKV, tid, kr, va, vb, qn);
    for (;;) {
        attn_stage(lds, tid, kr, va, vb, qn);
        __syncthreads();
        const int un = u + G; const bool has_next = un < NU;
        AttnDesc dn = d;
        if (has_next) { dn = attn_decode(un, S); attn_load(dn, QKV, tid, kr, va, vb, qn); }
        attn_compute(lds, d, OB, LSE, tid);
        if (!has_next) break;
        __syncthreads();
        d = dn; u = un;
    }
    __syncthreads();
}

__device__ __forceinline__ void phase_combine(const Params& p, int chunk, int row_begin, int nrows, int lane_in) {
    int lane = lane_in; asm volatile("" : "+v"(lane));
    const bf16* OB = (const bf16*)(p.ws + WS_OB); const float* LSE = (const float*)(p.ws + WS_LSE);
    const bf16* ZA = (const bf16*)(p.ws + (chunk == 0 ? WS_ZA : WS_ZA2)); const bf16* U = (const bf16*)(p.ws + WS_U); const bf16* T = (const bf16*)(p.ws + WS_T);
    const __amdgpu_buffer_rsrc_t a12_r = __builtin_amdgcn_make_buffer_rsrc((void*)(p.ws + WS_A12), 0, 2 * CH * 512 * 2, 0x00020000);
    const int S = chunk == 0 ? 16384 : 8192;
    f32x4 cw[3][2];
#pragma unroll
    for (int k = 0; k < 3; ++k) { cw[k][0] = *(const f32x4*)(p.conv_w + k * 512 + 8 * lane); cw[k][1] = *(const f32x4*)(p.conv_w + k * 512 + 8 * lane + 4); }
    const int hs = lane >> 3;
#pragma unroll 4
    for (int ri = 0; ri < nrows; ++ri) {
        const int row = row_begin + ri;
        const int s = row & (S - 1);
        const u32x4 zero = (u32x4){0u, 0u, 0u, 0u};
        const float l0 = LSE[(size_t)row * 24 + hs], l1 = LSE[(size_t)row * 24 + 8 + hs], l2 = LSE[(size_t)row * 24 + 16 + hs];
        const u32x4 o0 = __builtin_nontemporal_load((const u32x4*)(OB + (size_t)row * 1536 + 8 * lane)), o1 = __builtin_nontemporal_load((const u32x4*)(OB + (size_t)row * 1536 + 512 + 8 * lane)), o2 = __builtin_nontemporal_load((const u32x4*)(OB + (size_t)row * 1536 + 1024 + 8 * lane));
        const u32x4 za = __builtin_nontemporal_load((const u32x4*)(ZA + (size_t)row * 512 + 8 * lane));
        const u32x4 um = s > 0 ? *(const u32x4*)(U + (size_t)(row - 1) * 512 + 8 * lane) : zero;
        const u32x4 uc = *(const u32x4*)(U + (size_t)row * 512 + 8 * lane);
        const u32x4 up = s < S - 1 ? *(const u32x4*)(U + (size_t)(row + 1) * 512 + 8 * lane) : zero;
        const u32x4 tt = __builtin_nontemporal_load((const u32x4*)(T + (size_t)row * 512 + 8 * lane));
        const float mx = fmaxf(l0, fmaxf(l1, l2));
        float w0 = __builtin_amdgcn_exp2f(l0 - mx), w1 = __builtin_amdgcn_exp2f(l1 - mx), w2 = __builtin_amdgcn_exp2f(l2 - mx);
        const float inv = 1.f / (w0 + w1 + w2); w0 *= inv; w1 *= inv; w2 *= inv;
        f32x4 a0, a1, b0, b1, c0, c1, z0, z1;
        pg8::unpack8(o0, a0, a1); pg8::unpack8(o1, b0, b1); pg8::unpack8(o2, c0, c1); pg8::unpack8(za, z0, z1);
        const f32x4 r0 = z0 * (a0 * w0 + b0 * w1 + c0 * w2), r1 = z1 * (a1 * w0 + b1 * w1 + c1 * w2);
        pg8::st16_wt(a12_r, (unsigned)(row * 1024 + 16 * lane), pg8::pack8(r0, r1));
        f32x4 m0, m1, e0, e1, n0, n1, t0, t1;
        pg8::unpack8(um, m0, m1); pg8::unpack8(uc, e0, e1); pg8::unpack8(up, n0, n1); pg8::unpack8(tt, t0, t1);
        const f32x4 v0 = t0 * (cw[0][0] * m0 + cw[1][0] * e0 + cw[2][0] * n0), v1 = t1 * (cw[0][1] * m1 + cw[1][1] * e1 + cw[2][1] * n1);
        pg8::st16_wt(a12_r, (unsigned)((CH + row) * 1024 + 16 * lane), pg8::pack8(v0, v1));
    }
}

struct OutOrder {
    pg8::StaticOrder base; unsigned* cnt;
    __device__ bool next(int i, pg8::Unit& u) const { return base.next(i, u); }
    __device__ __forceinline__ void a_ready(const pg8::Unit&) const { pg8::panel_barrier<false>(cnt, 4u); }
    __device__ __forceinline__ void done(const pg8::Unit&) const {}
};
struct MergeOrder {
    pg8::StaticOrder base; int nM, nN; unsigned* cnt;
    __device__ void init(int G, int c) { base.init(CH, DM, G, c); nM = CH / 256; nN = DM / 256; }
    __device__ bool next(int i, pg8::Unit& u) const { pg8::Unit t; if (!base.next(i >> 1, t)) return false; const int h = i & 1; u.pm = t.pm + h * nM; u.pn = t.pn + h * nN; return true; }
    __device__ __forceinline__ void a_ready(const pg8::Unit& u) const { if (u.pm < nM) pg8::panel_barrier<false>(cnt, 4u); }
    __device__ __forceinline__ void done(const pg8::Unit&) const {}
};

#define XB_TMO      128
#define XB_XCNT(j)  (256  + 64 * (j))
#define XB_XSUB(j)  (1280 + 64 * (j))
#define XB_XGEN(j)  (2304 + 64 * (j))
#define XB_TOP      3328
#define XB_TOPGEN   3392
#define XCD_BAR_WORDS 3456
#define XB_SPIN_CAP (1u << 18)

__device__ __forceinline__ unsigned xb_ld(unsigned* p)              { return __hip_atomic_load(p, __ATOMIC_RELAXED, __HIP_MEMORY_SCOPE_AGENT); }
__device__ __forceinline__ unsigned xb_add(unsigned* p, unsigned v) { return __hip_atomic_fetch_add(p, v, __ATOMIC_RELAXED, __HIP_MEMORY_SCOPE_AGENT); }
__device__ __forceinline__ unsigned xb_xcc_id() { return (unsigned)__builtin_amdgcn_s_getreg((3 << 11) | 20) & 0xFu; }
#define XB_SPIN(cond, bar) do { unsigned _sp = 0; while (cond) { __builtin_amdgcn_s_sleep(1); \
    if ((++_sp & 255u) == 0u) { if (xb_ld(&(bar)[XB_TMO])) break; if (_sp > XB_SPIN_CAP) { atomicAdd(&(bar)[XB_TMO], 1u); break; } } } } while (0)

struct XcdBarrier {
    unsigned* bar; unsigned x;
    volatile LAS unsigned* st;
};

__device__ __forceinline__ XcdBarrier xcd_barrier_post(unsigned* bar, volatile LAS unsigned* st) {
    XcdBarrier b; b.bar = bar; b.x = xb_xcc_id(); b.st = st;
    if (threadIdx.x == 0) (void)xb_add(&bar[XB_XCNT(b.x)], 1u);
    return b;
}
__device__ __forceinline__ void xcd_barrier_complete(unsigned* bar, unsigned x, unsigned& nloc, unsigned& nx) {
    const unsigned G = gridDim.x * gridDim.y * gridDim.z;
    unsigned sum, cnt, mine, sp = 0u;
    for (;;) {
        sum = 0u; cnt = 0u; mine = 0u;
#pragma unroll
        for (unsigned j = 0; j < 16; ++j) { const unsigned c = xb_ld(&bar[XB_XCNT(j)]); sum += c; cnt += (c > 0u) ? 1u : 0u; mine = (j == x) ? c : mine; }
        if (sum == G) break;
        __builtin_amdgcn_s_sleep(1);
        if ((++sp & 255u) == 0u) { if (xb_ld(&bar[XB_TMO])) break; if (sp > XB_SPIN_CAP) { atomicAdd(&bar[XB_TMO], 1u); break; } }
    }
    nloc = mine > 0u ? mine : 1u; nx = cnt > 0u ? cnt : 1u;
}

__device__ __forceinline__ void xcd_barrier(const XcdBarrier& b) {
    asm volatile("s_waitcnt vmcnt(0)" ::: "memory");
    __syncthreads();
    if (threadIdx.x == 0) {
        unsigned* bar = b.bar;
        __builtin_amdgcn_s_waitcnt(0);
        unsigned nloc = b.st[0], nx = b.st[1];
        if (nloc == 0u) { xcd_barrier_complete(bar, b.x, nloc, nx); b.st[0] = nloc; b.st[1] = nx; }
        const unsigned old = xb_add(&bar[XB_XSUB(b.x)], 1u);
        const unsigned gen = old / nloc;
        if (old + 1u == (gen + 1u) * nloc) {
            __builtin_amdgcn_fence(__ATOMIC_RELEASE, "agent");
            asm volatile("s_waitcnt vmcnt(0)" ::: "memory");
            const unsigned og = xb_add(&bar[XB_TOP], 1u);
            const unsigned tg = og / nx;
            if (og + 1u == (tg + 1u) * nx) xb_add(&bar[XB_TOPGEN], 1u);
            else XB_SPIN(xb_ld(&bar[XB_TOPGEN]) == tg, bar);
            __builtin_amdgcn_fence(__ATOMIC_ACQUIRE, "agent");
            xb_add(&bar[XB_XGEN(b.x)], 1u);
            asm volatile("s_waitcnt vmcnt(0)" ::: "memory");
        } else {
            XB_SPIN(xb_ld(&bar[XB_XGEN(b.x)]) == gen, bar);
            __builtin_amdgcn_fence(__ATOMIC_ACQUIRE, "agent");
            asm volatile("s_waitcnt vmcnt(0)" ::: "memory");
        }
    }
    __syncthreads();
}

__global__ void __launch_bounds__(NTHREADS, 2) fwd_megakernel(Params p) {
    extern __shared__ __attribute__((aligned(16))) unsigned char lds_raw[];
    LAS unsigned char* lds = (LAS unsigned char*)lds_raw;
    cg::grid_group grid = cg::this_grid();
    const int tid = threadIdx.x, lane = tid & 63, wave = __builtin_amdgcn_readfirstlane(tid >> 6);
    const int G = gridDim.x, gw = blockIdx.x * NWAVES + wave, NGW = G * NWAVES;
    volatile LAS unsigned* bst = (volatile LAS unsigned*)(lds + BST_OFF);
    if (tid < 2) bst[tid] = 0u;
    unsigned* ctl = (unsigned*)(p.ws + WS_BAR);
    constexpr unsigned READY_MAGIC = 0x600DF1A6u;
    unsigned* ready = ctl + CTL_WORDS;
    if (p.use_cg_sync) grid.sync();
    if (blockIdx.x == 0) {
        for (int i = tid; i < CTL_WORDS / 64; i += NTHREADS) __hip_atomic_store(ctl + 64 * i, 0u, __ATOMIC_RELAXED, __HIP_MEMORY_SCOPE_AGENT);
        asm volatile("s_waitcnt vmcnt(0)" ::: "memory");
        __syncthreads();
        if (tid == 0) __hip_atomic_store(ready, READY_MAGIC, __ATOMIC_RELAXED, __HIP_MEMORY_SCOPE_AGENT);
    }
    phase_prologue(p, lds, gw, NGW, wave, lane);
    __syncthreads();
    if (blockIdx.x != 0) {
        if (tid == 0) { unsigned sp = 0u; while (__hip_atomic_load(ready, __ATOMIC_RELAXED, __HIP_MEMORY_SCOPE_AGENT) != READY_MAGIC) { __builtin_amdgcn_s_sleep(1); if (++sp > (1u << 24)) break; } }
        __syncthreads();
    }
    const XcdBarrier bar = xcd_barrier_post(ctl, bst);
    xcd_barrier(bar);

    pg8::StaticOrder St; St.init(CH, DM, G, (int)blockIdx.x);
    pg8::Unit tu; const bool has_tile = St.next(0, tu);
    const bool tail_first = true;
    const unsigned long long prog = tail_first ? 0x6353423130ull   : 0x6353243130ull  ;
    for (int step = 0; step < 10; ++step) {
        const int code = (int)((prog >> (4 * step)) & 15ull), op = code & 3, chunk = code >> 2;
        const pg8::bf16_t* XNc = (const pg8::bf16_t*)(p.ws + WS_XN) + (size_t)chunk * CH * DM;
        pg8::EpiP1 E1{(pg8::bf16_t*)(p.ws + WS_QKV), (pg8::bf16_t*)(p.ws + (chunk == 0 ? WS_ZA : WS_ZA2)), (pg8::bf16_t*)(p.ws + WS_U), (pg8::bf16_t*)(p.ws + WS_T), (pg8::bf16_t*)(p.ws + WS_GR), (pg8::bf16_t*)(p.ws + WS_GC), p.b_gate, 0};
        if (op == 3) { xcd_barrier(bar); }
        else if (op == 0) {
            pg8::Gemm g{XNc, (const pg8::bf16_t*)(p.ws + WS_WIN), CH, 20 * 256, DM};
            pg8::StaticOrder S; S.init(CH, 20 * 256, G, (int)blockIdx.x);
            pg8::gemm_phase<pg8::EpiP1, pg8::StaticOrder, true, true>(lds, g, S, E1);
            __syncthreads();
        } else if (op == 1) {
            phase_attention(p, lds, chunk, G, tid);
            {
                pg8::Gemm g{XNc, (const pg8::bf16_t*)(p.ws + WS_WIN) + (size_t)20 * 256 * DM, CH, 16 * 256, DM};
                pg8::StaticOrder S; S.init(CH, 16 * 256, G, (int)blockIdx.x);
                pg8::EpiP1 E2 = E1; E2.pn_off = 20;
                pg8::gemm_phase<pg8::EpiP1, pg8::StaticOrder, true, true>(lds, g, S, E2);
            }
        } else if (has_tile) {
            unsigned* pcnt = ctl + PANEL_CNT0 + (size_t)chunk * 64 * 3 * 64;
            int tl_ = (int)threadIdx.x; asm volatile("" : "+v"(tl_));
            phase_combine(p, chunk, tu.pm * 256 + tu.pn * 64 + wave * 8, 8, tl_ & 63);
            asm volatile("s_waitcnt vmcnt(0)" ::: "memory");
            {
                pg8::Gemm g{(const pg8::bf16_t*)(p.ws + WS_A12), (const pg8::bf16_t*)(p.ws + WS_WAC), 2 * CH, 2 * DM, 512};
                MergeOrder S; S.init(G, (int)blockIdx.x); S.cnt = pcnt + (size_t)tu.pm * 3 * 64 + 0 * 64;
                pg8::EpiMerge E{(const pg8::bf16_t*)(p.ws + WS_GR), (const pg8::bf16_t*)(p.ws + WS_GC), (pg8::bf16_t*)(p.ws + WS_MG), CH / 256, DM / 256};
                pg8::gemm_phase<pg8::EpiMerge, MergeOrder, true, true>(lds, g, S, E);
            }
            {
                pg8::Gemm g{(const pg8::bf16_t*)(p.ws + WS_MG), (const pg8::bf16_t*)(p.ws + WS_WO), CH, DM, DM};
                pg8::EpiOutNorm E{chunk == 0 ? p.x_prompt : p.x_sample, p.out + (size_t)chunk * CH * DM, p.final_g, (float*)(p.ws + WS_XB) + (size_t)chunk * 64 * 256 * 4, pcnt + 2 * 64};
                OutOrder So{St, pcnt + (size_t)tu.pm * 3 * 64 + 1 * 64};
                pg8::gemm_phase<pg8::EpiOutNorm, OutOrder, false, true>(lds, g, So, E);
            }
            __syncthreads();
        }
    }
    if (blockIdx.x == 0 && tid == 0) __hip_atomic_store(ready, 0u, __ATOMIC_RELAXED, __HIP_MEMORY_SCOPE_AGENT);
}

extern "C" void kernel_launch(void* const* d_in, const int* in_sizes, int n_in, void* d_out, int out_size, void* d_ws, size_t ws_size, hipStream_t stream) {
    static int grid = 0;
    if (grid == 0) {
        if (n_in != 10 || out_size != NTOK * DM || ws_size < WS_END) { fprintf(stderr, "kernel_launch: unexpected shapes / workspace (%d inputs, out %d, ws %zu)\n", n_in, out_size, ws_size); grid = -1; return; }
        int dev = 0, cus = 0, per_cu = 0;
        if (hipGetDevice(&dev) != hipSuccess || hipDeviceGetAttribute(&cus, hipDeviceAttributeMultiprocessorCount, dev) != hipSuccess) { grid = -1; return; }
        if (hipFuncSetAttribute((const void*)fwd_megakernel, hipFuncAttributeMaxDynamicSharedMemorySize, LDS_BYTES) != hipSuccess) { fprintf(stderr, "kernel_launch: hipFuncSetAttribute failed\n"); grid = -1; return; }
        if (hipOccupancyMaxActiveBlocksPerMultiprocessor(&per_cu, (const void*)fwd_megakernel, NTHREADS, LDS_BYTES) != hipSuccess || per_cu < 1) { fprintf(stderr, "kernel_launch: occupancy query says %d\n", per_cu); per_cu = 1; }
        (void)hipGetLastError();
        grid = cus;
    }
    if (grid < 0) return;
    Params p{};
    p.x_prompt = (const float*)d_in[0]; p.x_sample = (const float*)d_in[1]; p.norm_g = (const float*)d_in[2]; p.w_in = (const float*)d_in[3]; p.b_gate = (const float*)d_in[4];
    p.conv_w = (const float*)d_in[5]; p.w_attn_out = (const float*)d_in[6]; p.w_conv_out = (const float*)d_in[7]; p.w_o = (const float*)d_in[8]; p.final_g = (const float*)d_in[9];
    p.out = (float*)d_out; p.ws = (unsigned char*)d_ws;
    void* args[] = {&p};
    hipError_t e = hipLaunchCooperativeKernel((const void*)fwd_megakernel, dim3(grid), dim3(NTHREADS), args, LDS_BYTES, stream);
    if (e != hipSuccess) fprintf(stderr, "kernel_launch: cooperative launch failed: %s (grid %d)\n", hipGetErrorString(e), grid);
}
```

```cpp
#include <hip/hip_runtime.h>
#include <hip/hip_cooperative_groups.h>
#include <cstdio>
#include <cstdint>
namespace cg = cooperative_groups;
namespace pg8 {
#define PG8_LAS __attribute__((address_space(3)))
typedef unsigned short bf16_t;
typedef short bf16x8 __attribute__((ext_vector_type(8)));
typedef float f32x4 __attribute__((ext_vector_type(4)));
typedef unsigned u32x4 __attribute__((ext_vector_type(4)));
constexpr int BM = 256, BK = 64, HALF = 128, HTB = HALF * BK * 2  , STAGE_BYTES = 8 * HTB, NXCD = 8, WGM = 8;

__host__ __device__ __forceinline__ int lds_byte(int r, int c) { const int st = (r >> 4) * 2 + (c >> 5), rr = r & 15, cc = c & 31, ob = rr * 64 + cc * 2; return st * 1024 + (ob ^ (((ob >> 9) & 1) << 5)); }
__host__ __device__ __forceinline__ void stage_rc(int b, int& R, int& C) { const int st = b / 1024, sb = b % 1024, swz = sb ^ (((sb >> 9) & 1) << 5); R = (st >> 1) * 16 + swz / 64; C = (st & 1) * 32 + (swz % 64) / 2; }
__host__ __device__ __forceinline__ int perm32(int rho) { const int n = rho >> 4, i = rho & 15; return 8 * (i >> 2) + 4 * n + (i & 3); }

struct Unit { int pm, pn; };
struct Gemm { const bf16_t* A; const bf16_t* Bt; int M, N, K; };

struct StaticOrder {
    int nM, nN, nwg, G, c;
    __host__ __device__ void init(int M, int N, int G_, int c_) { nM = M / BM; nN = N / BM; nwg = nM * nN; G = G_; c = c_; }
    __host__ __device__ bool next(int i, Unit& u) const {
        const long L = (long)i * G + c; if (L >= nwg) return false;
        int wgid = (int)L; { const int q = nwg / NXCD, r = nwg % NXCD, xcd = wgid % NXCD, off = wgid / NXCD; wgid = (xcd < r ? xcd * (q + 1) : r * (q + 1) + (xcd - r) * q) + off; }
        const int nig = WGM * nN, gid = wgid / nig, fm = gid * WGM, gsz = (nM - fm) < WGM ? (nM - fm) : WGM;
        u.pm = fm + ((wgid % nig) % gsz); u.pn = (wgid % nig) / gsz; return true;
    }
    __device__ __forceinline__ void a_ready(const Unit&) const {}
    __device__ __forceinline__ void done(const Unit&) const {}
};
__device__ __forceinline__ unsigned cvt_pk_bf16(float lo, float hi) { unsigned r; asm volatile("v_cvt_pk_bf16_f32 %0, %1, %2" : "=v"(r) : "v"(lo), "v"(hi)); return r; }
__device__ __forceinline__ float bf_lo(unsigned w) { return __builtin_bit_cast(float, w << 16); }
__device__ __forceinline__ float bf_hi(unsigned w) { return __builtin_bit_cast(float, w & 0xffff0000u); }
__device__ __forceinline__ float sigmoid_f(float x) { x = fminf(fmaxf(x, -30.f), 30.f); return __builtin_amdgcn_rcpf(1.f + __expf(-x)); }
__device__ __forceinline__ f32x4 exp2n4(const f32x4& v) { const f32x4 t = v * (-1.4426950408889634f); f32x4 e; e[0] = __builtin_amdgcn_exp2f(t[0]); e[1] = __builtin_amdgcn_exp2f(t[1]); e[2] = __builtin_amdgcn_exp2f(t[2]); e[3] = __builtin_amdgcn_exp2f(t[3]); return e; }
__device__ __forceinline__ f32x4 rcp4(const f32x4& d) { f32x4 r; r[0] = __builtin_amdgcn_rcpf(d[0]); r[1] = __builtin_amdgcn_rcpf(d[1]); r[2] = __builtin_amdgcn_rcpf(d[2]); r[3] = __builtin_amdgcn_rcpf(d[3]); return r; }
__device__ __forceinline__ f32x4 silu4(const f32x4& v) { return v * rcp4(exp2n4(v) + 1.f); }
__device__ __forceinline__ u32x4 pack8(const f32x4& a, const f32x4& b) { u32x4 w; w.x = cvt_pk_bf16(a[0], a[1]); w.y = cvt_pk_bf16(a[2], a[3]); w.z = cvt_pk_bf16(b[0], b[1]); w.w = cvt_pk_bf16(b[2], b[3]); return w; }
__device__ __forceinline__ void unpack8(const u32x4& w, f32x4& a, f32x4& b) { a[0] = bf_lo(w.x); a[1] = bf_hi(w.x); a[2] = bf_lo(w.y); a[3] = bf_hi(w.y); b[0] = bf_lo(w.z); b[1] = bf_hi(w.z); b[2] = bf_lo(w.w); b[3] = bf_hi(w.w); }

__device__ __forceinline__ void st16_wt(__amdgpu_buffer_rsrc_t r, unsigned byte_off, u32x4 v) { __builtin_amdgcn_raw_buffer_store_b128(v, r, byte_off, 0, 16); }
__device__ __forceinline__ unsigned dpp_swap1(unsigned v) { unsigned r; asm volatile("s_nop 1\n\tv_mov_b32_dpp %0, %1 quad_perm:[1,0,3,2] row_mask:0xf bank_mask:0xf bound_ctrl:1" : "=v"(r) : "v"(v)); return r; }
__device__ __forceinline__ void store_lines(bf16_t* rowp_even, int pitch, bool odd, const u32x4& P0, const u32x4& P1) {
    u32x4 snd, rcv;
#pragma unroll
    for (int k = 0; k < 4; ++k) snd[k] = odd ? P0[k] : P1[k];
#pragma unroll
    for (int k = 0; k < 4; ++k) rcv[k] = dpp_swap1(snd[k]);
    u32x4 A, B;
#pragma unroll
    for (int k = 0; k < 4; ++k) { A[k] = odd ? rcv[k] : P0[k]; B[k] = odd ? P1[k] : rcv[k]; }
    bf16_t* p = rowp_even + (odd ? 32 : 0);
    *(u32x4*)p = A; *(u32x4*)(p + pitch) = B;
}
__device__ __forceinline__ void store_lines_f32_nt(float* rowp_even, int pitch, bool odd, const f32x4& P0, const f32x4& P1) {
    f32x4 snd, rcv, A, B;
#pragma unroll
    for (int k = 0; k < 4; ++k) snd[k] = odd ? P0[k] : P1[k];
#pragma unroll
    for (int k = 0; k < 4; ++k) rcv[k] = __shfl_xor(snd[k], 1);
#pragma unroll
    for (int k = 0; k < 4; ++k) { A[k] = odd ? rcv[k] : P0[k]; B[k] = odd ? P1[k] : rcv[k]; }
    float* p = rowp_even + (odd ? 16 : 0);
    __builtin_nontemporal_store(A, (f32x4*)p); __builtin_nontemporal_store(B, (f32x4*)(p + pitch));
}
__device__ __forceinline__ void load_lines_f32_nt(const float* rowp_even, int pitch, bool odd, f32x4& P0, f32x4& P1) {
    const float* p = rowp_even + (odd ? 16 : 0);
    const f32x4 A = __builtin_nontemporal_load((const f32x4*)p), B = __builtin_nontemporal_load((const f32x4*)(p + pitch));
    f32x4 snd, rcv;
#pragma unroll
    for (int k = 0; k < 4; ++k) snd[k] = odd ? A[k] : B[k];
#pragma unroll
    for (int k = 0; k < 4; ++k) rcv[k] = __shfl_xor(snd[k], 1);
#pragma unroll
    for (int k = 0; k < 4; ++k) { P0[k] = odd ? rcv[k] : A[k]; P1[k] = odd ? B[k] : rcv[k]; }
}
constexpr float QSCALE = 0.125f * 1.4426950408889634f;

struct EpiP1 {
    static constexpr bool PERM = true, AFTER_DRAIN = false;
    bf16_t *QKV, *ZA, *U, *T, *GR, *GC; const float* b_gate; int pn_off;
    __device__ __forceinline__ void acc_init(f32x4 (&acc)[2][2][4][2], const Unit&, int, int, int, int) const {
#pragma unroll
        for (int a = 0; a < 2; ++a)
#pragma unroll
            for (int b = 0; b < 2; ++b)
#pragma unroll
                for (int m = 0; m < 4; ++m)
#pragma unroll
                    for (int n = 0; n < 2; ++n) acc[a][b][m][n] = (f32x4){0.f, 0.f, 0.f, 0.f};
    }
    __device__ __forceinline__ bool keep(const Unit&) const { return false; }
    __device__ __forceinline__ void operator()(f32x4 (&acc)[2][2][4][2], const Unit& u, int wr, int wc, int fr, int fq) const {
        const int row0 = u.pm * BM + wr * 64 + fr, cl = wc * 32 + 8 * fq, pn = u.pn + pn_off;
        const int rowe0 = u.pm * BM + wr * 64 + (fr & ~1), cl2 = wc * 64 + 8 * fq; const bool odd = fr & 1;
        if (pn < 18) {
            const float sc = pn < 6 ? QSCALE : 1.f;
#pragma unroll
            for (int ai = 0; ai < 2; ++ai)
#pragma unroll
                for (int m = 0; m < 4; ++m) { bf16_t* rowe = QKV + (size_t)(rowe0 + ai * HALF + m * 16) * 4608 + pn * 256 + cl2;
                    store_lines(rowe, 4608, odd, pack8(acc[ai][0][m][0] * sc, acc[ai][0][m][1] * sc), pack8(acc[ai][1][m][0] * sc, acc[ai][1][m][1] * sc)); }
        } else if (pn < 20) {
#pragma unroll
            for (int ai = 0; ai < 2; ++ai)
#pragma unroll
                for (int m = 0; m < 4; ++m) { bf16_t* rowe = ZA + (size_t)(rowe0 + ai * HALF + m * 16) * 512 + (pn - 18) * 256 + cl2;
                    u32x4 pz[2];
#pragma unroll
                    for (int bj = 0; bj < 2; ++bj) { f32x4 v0 = acc[ai][bj][m][0], v1 = acc[ai][bj][m][1];
                        { v0 = silu4(v0); v1 = silu4(v1); }
                        pz[bj] = pack8(v0, v1); }
                    store_lines(rowe, 512, odd, pz[0], pz[1]); }
        } else if (pn < 24) {
#pragma unroll
            for (int ai = 0; ai < 2; ++ai)
#pragma unroll
                for (int m = 0; m < 4; ++m) { bf16_t* rowp = U + (size_t)(row0 + ai * HALF + m * 16) * 512 + (pn - 20) * 128 + cl;
                    *(u32x4*)rowp = pack8(acc[ai][0][m][0] * acc[ai][1][m][0], acc[ai][0][m][1] * acc[ai][1][m][1]); }
        } else if (pn < 28) {
#pragma unroll
            for (int ai = 0; ai < 2; ++ai)
#pragma unroll
                for (int m = 0; m < 4; ++m) { bf16_t* rowp = T + (size_t)(row0 + ai * HALF + m * 16) * 512 + (pn - 24) * 128 + cl;
                    f32x4 v0 = acc[ai][1][m][0], v1 = acc[ai][1][m][1];
                    { v0 = silu4(v0); v1 = silu4(v1); }
                    *(u32x4*)rowp = pack8(acc[ai][0][m][0] * v0, acc[ai][0][m][1] * v1); }
        } else {
            const int col = (pn - 28) * 128 + cl;
            const f32x4 ba0 = *(const f32x4*)(b_gate + col), ba1 = *(const f32x4*)(b_gate + col + 4), bc0 = *(const f32x4*)(b_gate + 1024 + col), bc1 = *(const f32x4*)(b_gate + 1024 + col + 4);
#pragma unroll
            for (int ai = 0; ai < 2; ++ai)
#pragma unroll
                for (int m = 0; m < 4; ++m) { const size_t off = (size_t)(row0 + ai * HALF + m * 16) * 1024 + col;
                    f32x4 a0 = acc[ai][0][m][0] + ba0, a1 = acc[ai][0][m][1] + ba1, c0 = acc[ai][1][m][0] + bc0, c1 = acc[ai][1][m][1] + bc1;
                    {
                        const f32x4 lo = (f32x4){-30.f, -30.f, -30.f, -30.f};
                        const f32x4 dc0 = exp2n4(__builtin_elementwise_max(c0, lo)) + 1.f, dc1 = exp2n4(__builtin_elementwise_max(c1, lo)) + 1.f;
                        const f32x4 ra0 = rcp4(exp2n4(a0) + 1.f), ra1 = rcp4(exp2n4(a1) + 1.f);
                        a0 = dc0 * ra0; a1 = dc1 * ra1; c0 = rcp4(dc0); c1 = rcp4(dc1); }
                    *(u32x4*)(GR + off) = pack8(a0, a1); *(u32x4*)(GC + off) = pack8(c0, c1); }
        }
    }
};

struct EpiMerge {
    static constexpr bool PERM = true, AFTER_DRAIN = false;
    const bf16_t *GR, *GC; bf16_t* MG; int nM, nN;
    __device__ __forceinline__ void acc_init(f32x4 (&acc)[2][2][4][2], const Unit&, int, int, int, int) const {
#pragma unroll
        for (int a = 0; a < 2; ++a)
#pragma unroll
            for (int b = 0; b < 2; ++b)
#pragma unroll
                for (int m = 0; m < 4; ++m)
#pragma unroll
                    for (int n = 0; n < 2; ++n) acc[a][b][m][n] = (f32x4){0.f, 0.f, 0.f, 0.f};
    }
    __device__ __forceinline__ bool keep(const Unit& u) const { return u.pm < nM; }
    __device__ __forceinline__ void operator()(f32x4 (&acc)[2][2][4][2], const Unit& u, int wr, int wc, int fr, int fq) const {
        const bool h0 = u.pm < nM; const int pm = h0 ? u.pm : u.pm - nM, pn = h0 ? u.pn : u.pn - nN;
        const int row0 = pm * BM + wr * 64 + fr, col0 = pn * BM + wc * 32 + 8 * fq;
        const bf16_t* G = h0 ? GR : GC;
        const __amdgpu_buffer_rsrc_t mg_r = __builtin_amdgcn_make_buffer_rsrc((void*)MG, 0, 16384 * 1024 * 2, 0x00020000);
#pragma unroll
        for (int ai = 0; ai < 2; ++ai)
#pragma unroll
            for (int m = 0; m < 4; ++m) { const size_t off = (size_t)(row0 + ai * HALF + m * 16) * 1024 + col0;
#pragma unroll
                for (int bj = 0; bj < 2; ++bj) { const u32x4 w = __builtin_nontemporal_load((const u32x4*)(G + off + bj * HALF)); f32x4 g0, g1; unpack8(w, g0, g1);
                    acc[ai][bj][m][0] *= g0; acc[ai][bj][m][1] *= g1;
                    if (!h0) st16_wt(mg_r, (unsigned)((off + bj * HALF) * 2), pack8(acc[ai][bj][m][0], acc[ai][bj][m][1])); } }
    }
};

template <bool DRAIN = true, bool ACQ = true> __device__ __forceinline__ void panel_barrier(unsigned* cnt, unsigned want) {
    if (DRAIN) asm volatile("s_waitcnt vmcnt(0)" ::: "memory");
    __syncthreads();
    if (threadIdx.x == 0) {
        __hip_atomic_fetch_add(cnt, 1u, __ATOMIC_RELAXED, __HIP_MEMORY_SCOPE_AGENT);
        unsigned sp = 0u;
        while (__hip_atomic_load(cnt, __ATOMIC_RELAXED, __HIP_MEMORY_SCOPE_AGENT) < want) { __builtin_amdgcn_s_sleep(1); if (++sp > (1u << 22)) break; }
        if (ACQ) { __builtin_amdgcn_fence(__ATOMIC_ACQUIRE, "agent"); asm volatile("s_waitcnt vmcnt(0)" ::: "memory"); }
    }
    __syncthreads();
}
struct EpiOutNorm {
    static constexpr bool PERM = false, AFTER_DRAIN = true;
    const float* x; float* out; const float* fg; float* XB; unsigned* cnt;
    __device__ __forceinline__ bool keep(const Unit&) const { return false; }
    __device__ __forceinline__ void acc_init(f32x4 (&acc)[2][2][4][2], const Unit& u, int wr, int wc, int fr, int fq) const {
        const int col0 = u.pn * BM + wc * 32 + 4 * fq;
        asm volatile("s_waitcnt vmcnt(0)" ::: "memory");
#pragma unroll
        for (int ai = 0; ai < 2; ++ai)
#pragma unroll
            for (int m = 0; m < 4; ++m) { const size_t offe = (size_t)(u.pm * BM + ai * HALF + wr * 64 + m * 16 + (fr & ~1)) * 1024 + col0;
#pragma unroll
                for (int bj = 0; bj < 2; ++bj) load_lines_f32_nt(x + offe + bj * HALF, 1024, fr & 1, acc[ai][bj][m][0], acc[ai][bj][m][1]); }
    }
    __device__ __forceinline__ void fused(f32x4 (&acc)[2][2][4][2], const Unit& u, int wr, int wc, int fr, int fq, PG8_LAS unsigned char* lds, int wid, int lane) const {
        PG8_LAS float* P = (PG8_LAS float*)lds;
        PG8_LAS float* Sr = (PG8_LAS float*)(lds + 4096);
        const int col0 = u.pn * BM + wc * 32 + 4 * fq;
#pragma unroll
        for (int ai = 0; ai < 2; ++ai)
#pragma unroll
            for (int m = 0; m < 4; ++m) { const int rl = ai * HALF + wr * 64 + m * 16 + fr; float ss = 0.f;
#pragma unroll
                for (int bj = 0; bj < 2; ++bj)
#pragma unroll
                    for (int n = 0; n < 2; ++n) { const f32x4 o = acc[ai][bj][m][n]; ss += (o[0] * o[0] + o[1] * o[1]) + (o[2] * o[2] + o[3] * o[3]); }
                ss += __shfl_xor(ss, 16); ss += __shfl_xor(ss, 32);
                if (fq == 0) P[rl * 4 + wc] = ss; }
        asm volatile("s_waitcnt lgkmcnt(0)" ::: "memory"); __builtin_amdgcn_s_barrier(); asm volatile("" ::: "memory");
        const int tid = wid * 64 + lane;
        float* xb = XB + ((size_t)u.pm * 256 + (tid & 255)) * 4;
        if (tid < 256) { const f32x4 pv = *(const PG8_LAS f32x4*)(P + tid * 4); __hip_atomic_store(xb + u.pn, (pv[0] + pv[1]) + (pv[2] + pv[3]), __ATOMIC_RELAXED, __HIP_MEMORY_SCOPE_AGENT); }
        panel_barrier<true, false>(cnt + (size_t)u.pm * 3 * 64, 4u);
        if (tid < 256) { float tv[4];
#pragma unroll
            for (int k = 0; k < 4; ++k) tv[k] = __hip_atomic_load(xb + k, __ATOMIC_RELAXED, __HIP_MEMORY_SCOPE_AGENT);
            const float tot = (tv[0] + tv[1]) + (tv[2] + tv[3]); Sr[tid] = 1.f / sqrtf(tot * (1.f / 1024.f) + 1e-6f); }
        asm volatile("s_waitcnt lgkmcnt(0)" ::: "memory"); __builtin_amdgcn_s_barrier(); asm volatile("" ::: "memory");
        f32x4 gv[2][2];
#pragma unroll
        for (int bj = 0; bj < 2; ++bj)
#pragma unroll
            for (int n = 0; n < 2; ++n) gv[bj][n] = *(const f32x4*)(fg + col0 + bj * HALF + n * 16);
#pragma unroll
        for (int ai = 0; ai < 2; ++ai)
#pragma unroll
            for (int m = 0; m < 4; ++m) { const int rl = ai * HALF + wr * 64 + m * 16 + fr; const size_t offe = (size_t)(u.pm * BM + (rl & ~1)) * 1024 + col0; const float rs = Sr[rl];
#pragma unroll
                for (int bj = 0; bj < 2; ++bj) store_lines_f32_nt(out + offe + bj * HALF, 1024, fr & 1, acc[ai][bj][m][0] * rs * gv[bj][0], acc[ai][bj][m][1] * rs * gv[bj][1]); }
    }
};

template <class Epi, class Sched, bool ALIGN_EPI = false, bool SP2 = false>
__device__ __forceinline__ void gemm_phase(PG8_LAS unsigned char* lds, const Gemm g, const Sched& S, const Epi& E) {
    int tid_ = threadIdx.x; asm volatile("" : "+v"(tid_));
    const int tid = tid_, wid = __builtin_amdgcn_readfirstlane(tid >> 6), lane = tid & 63, wr = wid >> 2, wc = wid & 3, fr = lane & 15, fq = lane >> 4;
    const int K = g.K, nt = K / BK;
    unsigned voffA[2], voffB[2];
#pragma unroll
    for (int i = 0; i < 2; ++i) { int R, C; stage_rc(tid * 16 + i * 8192, R, C); const int Rb = Epi::PERM ? ((R & ~31) + perm32(R & 31)) : R;
        voffA[i] = (unsigned)(R * K + C) * 2u; voffB[i] = (unsigned)(Rb * K + C) * 2u; }
    const size_t kstep = (size_t)(BK * 2);
    const size_t hstep = (size_t)HALF * K * 2;
    const size_t tstep = 2 * hstep;
    const unsigned ldsw = (unsigned)wid * 1024u;
    const int aoff = lds_byte(wr * 64 + fr, fq * 8), boff = lds_byte(wc * 32 + fr, fq * 8);
#define PG8_SA(b, h) (((b) * 2 + (h)) * HTB)
#define PG8_SB(b, h) ((4 + (b) * 2 + (h)) * HTB)
#define PG8_STAGE(bufoff, gbase, voff) do { _Pragma("unroll") for (int _i = 0; _i < 2; ++_i) \
        __builtin_amdgcn_global_load_lds((const unsigned*)((const char*)(gbase) + (voff)[_i]), (PG8_LAS unsigned*)(lds + (bufoff) + ldsw + _i * 8192), 16, 0, 0); } while (0)
#define PG8_LDA(dst, b, h) do { _Pragma("unroll") for (int m = 0; m < 4; ++m) _Pragma("unroll") for (int k = 0; k < 2; ++k) dst[m][k] = *(const PG8_LAS bf16x8*)(lds + PG8_SA(b, h) + aoff + m * 2048 + k * 1024); } while (0)
#define PG8_LDB(dst, b, h) do { _Pragma("unroll") for (int n = 0; n < 2; ++n) _Pragma("unroll") for (int k = 0; k < 2; ++k) dst[n][k] = *(const PG8_LAS bf16x8*)(lds + PG8_SB(b, h) + boff + n * 2048 + k * 1024); } while (0)
#define PG8_MMA(ai, bj, At, Bt) do { __builtin_amdgcn_s_setprio(1); _Pragma("unroll") for (int m = 0; m < 4; ++m) _Pragma("unroll") for (int n = 0; n < 2; ++n) _Pragma("unroll") for (int k = 0; k < 2; ++k) \
        acc[ai][bj][m][n] = __builtin_amdgcn_mfma_f32_16x16x32_bf16(Bt[n][k], At[m][k], acc[ai][bj][m][n], 0, 0, 0); __builtin_amdgcn_s_setprio(0); } while (0)
#define PG8_WAIT_V(n) asm volatile("s_waitcnt vmcnt(" #n ")" ::: "memory")
#define PG8_WAIT_L(n) asm volatile("s_waitcnt lgkmcnt(" #n ")" ::: "memory")
#define PG8_BAR __builtin_amdgcn_s_barrier()
#define PG8_SCHED __builtin_amdgcn_sched_barrier(0)
    Unit cur, nxt; int ui = 0;
    if (!S.next(0, cur)) return;
    f32x4 acc[2][2][4][2];
    E.acc_init(acc, cur, wr, wc, fr, fq);
    bf16x8 At[4][2], B0[2][2], B1[2][2];
    const char* cA = (const char*)g.A + (size_t)cur.pm * tstep; const char* cB = (const char*)g.Bt + (size_t)cur.pn * tstep;
    if constexpr (!SP2) S.a_ready(cur);
    if constexpr (SP2) {
        PG8_STAGE(PG8_SB(0, 0), cB, voffB); PG8_STAGE(PG8_SB(0, 1), cB + hstep, voffB); S.a_ready(cur);
        PG8_STAGE(PG8_SA(0, 0), cA, voffA); PG8_STAGE(PG8_SA(0, 1), cA + hstep, voffA);
        if (wr == 1) PG8_BAR;
        PG8_WAIT_V(2); PG8_BAR;
        PG8_STAGE(PG8_SB(1, 0), cB + kstep, voffB); PG8_STAGE(PG8_SA(1, 0), cA + kstep, voffA); PG8_STAGE(PG8_SB(1, 1), cB + hstep + kstep, voffB);
        PG8_WAIT_V(6); PG8_BAR;
    } else {
        PG8_STAGE(PG8_SB(0, 0), cB, voffB); PG8_STAGE(PG8_SA(0, 0), cA, voffA); PG8_STAGE(PG8_SB(0, 1), cB + hstep, voffB); PG8_STAGE(PG8_SA(0, 1), cA + hstep, voffA);
        if (wr == 1) PG8_BAR;
        PG8_WAIT_V(4); PG8_BAR;
        PG8_STAGE(PG8_SB(1, 0), cB + kstep, voffB); PG8_STAGE(PG8_SA(1, 0), cA + kstep, voffA); PG8_STAGE(PG8_SB(1, 1), cB + hstep + kstep, voffB);
        PG8_WAIT_V(6); PG8_BAR;
    }
    for (;;) {
        const bool has_next = S.next(ui + 1, nxt);
        const char* nA = has_next ? (const char*)g.A + (size_t)nxt.pm * tstep : cA; const char* nB = has_next ? (const char*)g.Bt + (size_t)nxt.pn * tstep : cB;
        for (int t = 0; t < nt; t += 2) {
            const bool last = (t == nt - 2);
            const char* a1 = cA + (size_t)(t + 1) * kstep;
            const char* a2 = last ? nA : cA + (size_t)(t + 2) * kstep; const char* b2 = last ? nB : cB + (size_t)(t + 2) * kstep;
            const char* a3 = a2 + kstep; const char* b3 = b2 + kstep;
            if (last && has_next) S.a_ready(nxt);
            if constexpr (SP2) {
            PG8_LDB(B0, 0, 0); PG8_LDB(B1, 0, 1); PG8_SCHED; PG8_LDA(At, 0, 0); PG8_STAGE(PG8_SA(1, 1), a1 + hstep, voffA);
            PG8_WAIT_V(8); PG8_WAIT_L(0); PG8_BAR; PG8_MMA(0, 0, At, B0); PG8_MMA(0, 1, At, B1); PG8_BAR; PG8_SCHED;
            PG8_LDA(At, 0, 1); PG8_STAGE(PG8_SB(0, 0), b2, voffB); PG8_STAGE(PG8_SB(0, 1), b2 + hstep, voffB); PG8_STAGE(PG8_SA(0, 0), a2, voffA);
            PG8_WAIT_V(8); PG8_WAIT_L(0); PG8_BAR; PG8_MMA(1, 0, At, B0); PG8_MMA(1, 1, At, B1); PG8_BAR; PG8_SCHED;
            PG8_LDB(B0, 1, 0); PG8_LDB(B1, 1, 1); PG8_SCHED; PG8_LDA(At, 1, 0); PG8_STAGE(PG8_SA(0, 1), a2 + hstep, voffA);
            PG8_WAIT_V(8); PG8_WAIT_L(0); PG8_BAR; PG8_MMA(0, 0, At, B0); PG8_MMA(0, 1, At, B1); PG8_BAR; PG8_SCHED;
            PG8_LDA(At, 1, 1); PG8_STAGE(PG8_SB(1, 0), b3, voffB); PG8_STAGE(PG8_SB(1, 1), b3 + hstep, voffB); PG8_STAGE(PG8_SA(1, 0), a3, voffA);
            PG8_WAIT_V(8); PG8_WAIT_L(0); PG8_BAR; PG8_MMA(1, 0, At, B0); PG8_MMA(1, 1, At, B1); PG8_BAR; PG8_SCHED;
            } else {
            PG8_LDB(B0, 0, 0); PG8_SCHED; PG8_LDA(At, 0, 0); PG8_STAGE(PG8_SA(1, 1), a1 + hstep, voffA);
            PG8_WAIT_L(8); PG8_BAR; PG8_WAIT_L(0); PG8_MMA(0, 0, At, B0); PG8_BAR; PG8_SCHED;
            PG8_LDB(B1, 0, 1); PG8_STAGE(PG8_SB(0, 0), b2, voffB);
            PG8_BAR; PG8_WAIT_L(0); PG8_MMA(0, 1, At, B1); PG8_BAR;
            PG8_LDA(At, 0, 1); PG8_STAGE(PG8_SA(0, 0), a2, voffA);
            PG8_BAR; PG8_WAIT_L(0); PG8_MMA(1, 0, At, B0); PG8_BAR; PG8_SCHED;
            PG8_STAGE(PG8_SB(0, 1), b2 + hstep, voffB);
            PG8_WAIT_V(6); PG8_BAR; PG8_MMA(1, 1, At, B1); PG8_BAR;
            PG8_LDB(B0, 1, 0); PG8_SCHED; PG8_LDA(At, 1, 0); PG8_STAGE(PG8_SA(0, 1), a2 + hstep, voffA);
            PG8_WAIT_L(8); PG8_BAR; PG8_WAIT_L(0); PG8_MMA(0, 0, At, B0); PG8_BAR; PG8_SCHED;
            PG8_LDB(B1, 1, 1); PG8_STAGE(PG8_SB(1, 0), b3, voffB);
            PG8_BAR; PG8_WAIT_L(0); PG8_MMA(0, 1, At, B1); PG8_BAR;
            PG8_LDA(At, 1, 1); PG8_STAGE(PG8_SA(1, 0), a3, voffA);
            PG8_BAR; PG8_WAIT_L(0); PG8_MMA(1, 0, At, B0); PG8_BAR; PG8_SCHED;
            PG8_STAGE(PG8_SB(1, 1), b3 + hstep, voffB);
            PG8_WAIT_V(6); PG8_BAR; PG8_MMA(1, 1, At, B1); PG8_BAR;
            }
        }
        if constexpr (ALIGN_EPI) { if (wr == 0) PG8_BAR; }
        if constexpr (!Epi::AFTER_DRAIN) { E(acc, cur, wr, wc, fr, fq); S.done(cur); }
        if (!has_next) break;
        if (!E.keep(cur)) {
#pragma unroll
        for (int a = 0; a < 2; ++a)
#pragma unroll
            for (int b = 0; b < 2; ++b)
#pragma unroll
                for (int m = 0; m < 4; ++m)
#pragma unroll
                    for (int n = 0; n < 2; ++n) acc[a][b][m][n] = (f32x4){0.f, 0.f, 0.f, 0.f};
        }
        cur = nxt; cA = nA; cB = nB; ++ui;
        if constexpr (ALIGN_EPI) { if (wr == 1) PG8_BAR; }
    }
    PG8_WAIT_V(0);
    if constexpr (!ALIGN_EPI) { if (wr == 0) PG8_BAR; }
    PG8_BAR;
    if constexpr (Epi::AFTER_DRAIN) { E.fused(acc, cur, wr, wc, fr, fq, lds, wid, lane); S.done(cur); }
#undef PG8_SA
#undef PG8_SB
#undef PG8_STAGE
#undef PG8_LDA
#undef PG8_LDB
#undef PG8_MMA
#undef PG8_WAIT_V
#undef PG8_WAIT_L
#undef PG8_BAR
#undef PG8_SCHED
}
}

#define LAS __attribute__((address_space(3)))
typedef unsigned short bf16;
typedef unsigned u32x4 __attribute__((ext_vector_type(4)));
typedef unsigned u32x2 __attribute__((ext_vector_type(2)));
typedef float f32x4 __attribute__((ext_vector_type(4)));
typedef float f32x16 __attribute__((ext_vector_type(16)));
typedef short bf16x8 __attribute__((ext_vector_type(8)));

constexpr int DM = 1024, NTOK = 32768, CH = 16384, NCHUNK = 2, INW = 9216, QP = 4608;
constexpr float RMS_EPS = 1e-6f;
constexpr size_t MiB = 1u << 20;
constexpr size_t WS_WIN = 0, WS_WAC = 18 * MiB, WS_WO = 20 * MiB, WS_SS = 22 * MiB, WS_LSE = 23 * MiB, WS_XN = 32 * MiB, WS_QKV = 96 * MiB,
                 WS_ZA = 240 * MiB, WS_U = 256 * MiB, WS_T = 272 * MiB, WS_GR = 288 * MiB, WS_GC = 320 * MiB, WS_A12 = 352 * MiB, WS_MG = 384 * MiB, WS_OB = 416 * MiB  , WS_ZA2 = 464 * MiB  , WS_END = 480 * MiB;
constexpr size_t WS_XB = WS_SS;
constexpr size_t WS_BAR = WS_SS + 768 * 1024;
constexpr int CTL_WORDS = 32768, PANEL_CNT0 = 4096;
constexpr int NWAVES = 8, NTHREADS = 512;
constexpr int LDS_BYTES = 147456, BST_OFF = 146432;

__device__ __forceinline__ unsigned f2bf(float f) { unsigned u = __builtin_bit_cast(unsigned, f); return (u + 0x7fffu + ((u >> 16) & 1u)) >> 16; }
__device__ __forceinline__ unsigned pk2(float lo, float hi) { return f2bf(lo) | (f2bf(hi) << 16); }
__device__ __forceinline__ float wave_sum(float v) {
#pragma unroll
    for (int o = 1; o < 64; o <<= 1) v += __shfl_xor(v, o);
    return v;
}

__device__ __forceinline__ int win_dest(int e) {
    if (e < 5120) { const int Lb = e & 255; return (e & ~255) + 128 * ((Lb >> 5) & 1) + 32 * (Lb >> 6) + (Lb & 31); }
    if (e < 7168) { const int i = (e - 5120) & 511, kind = (e - 5120) >> 9;
        const int j = i >> 7, c = i & 127; const int tile = ((kind & 1) ? 24 : 20) + j; return tile * 256 + ((kind >> 1) ? 128 : 0) + c; }
    { const int i = (e - 7168) & 1023, isc = (e - 7168) >> 10; const int j = i >> 7, c = i & 127; return (28 + j) * 256 + (isc ? 128 : 0) + c; }
}
__device__ __forceinline__ void p0_transpose_item(const float* W, int K, int N, bf16* WT, int dest_row0, int k0, int n0, LAS float* scr, int lane) {
#pragma unroll 8
    for (int i = 0; i < 32; ++i) { const int kk = 2 * i + (lane >> 5); scr[kk * 33 + (lane & 31)] = __builtin_nontemporal_load(W + (size_t)(k0 + kk) * N + n0 + (lane & 31)); }
    asm volatile("s_waitcnt lgkmcnt(0)" ::: "memory");
    const int c = lane & 7;
#pragma unroll
    for (int j = 0; j < 4; ++j) { const int n = (lane >> 3) + 8 * j; const LAS float* s = scr + (8 * c) * 33 + n;
        u32x4 o; o.x = pk2(s[0 * 33], s[1 * 33]); o.y = pk2(s[2 * 33], s[3 * 33]); o.z = pk2(s[4 * 33], s[5 * 33]); o.w = pk2(s[6 * 33], s[7 * 33]);
        *(u32x4*)(WT + (size_t)(dest_row0 + n) * K + k0 + 8 * c) = o; }
    asm volatile("s_waitcnt lgkmcnt(0)" ::: "memory");
}

struct Params {
    const float *x_prompt, *x_sample, *norm_g, *w_in, *b_gate, *conv_w, *w_attn_out, *w_conv_out, *w_o, *final_g;
    float* out; unsigned char* ws;
    int use_cg_sync, pad;
};

__device__ __forceinline__ const float* xrow_ptr(const Params& p, int row) { return row < CH ? p.x_prompt + (size_t)row * DM : p.x_sample + (size_t)(row - CH) * DM; }

__device__ __forceinline__ void phase_prologue(const Params& p, LAS unsigned char* lds, int gw, int NGW, int wave, int lane) {
    LAS float* scr = (LAS float*)(lds + wave * 16384);
    bf16* WIN = (bf16*)(p.ws + WS_WIN); bf16* WAC = (bf16*)(p.ws + WS_WAC); bf16* WO = (bf16*)(p.ws + WS_WO);
    constexpr int I_IN = (DM / 64) * (INW / 32), I_A = (512 / 64) * (DM / 32), I_O = (DM / 64) * (DM / 32);
    constexpr int NITEMS = I_IN + 2 * I_A + I_O;
    for (int it = gw; it < NITEMS; it += NGW) {
        int r = it;
        if (r < I_IN) { const int nblk = INW / 32, kb = r / nblk, nb = r % nblk; p0_transpose_item(p.w_in, DM, INW, WIN, win_dest(32 * nb), 64 * kb, 32 * nb, scr, lane); continue; } r -= I_IN;
        if (r < I_A) { const int nblk = DM / 32, kb = r / nblk, nb = r % nblk; p0_transpose_item(p.w_attn_out, 512, DM, WAC, 32 * nb, 64 * kb, 32 * nb, scr, lane); continue; } r -= I_A;
        if (r < I_A) { const int nblk = DM / 32, kb = r / nblk, nb = r % nblk; p0_transpose_item(p.w_conv_out, 512, DM, WAC, 1024 + 32 * nb, 64 * kb, 32 * nb, scr, lane); continue; } r -= I_A;
        { const int nblk = DM / 32, kb = r / nblk, nb = r % nblk; p0_transpose_item(p.w_o, DM, DM, WO, 32 * nb, 64 * kb, 32 * nb, scr, lane); }
    }
    bf16* XN = (bf16*)(p.ws + WS_XN);
    f32x4 gv[4];
#pragma unroll
    for (int j = 0; j < 4; ++j) gv[j] = *((const f32x4*)p.norm_g + lane + 64 * j);
    for (int m = gw; m < NTOK; m += NGW) {
        const f32x4* xr = (const f32x4*)xrow_ptr(p, m) + lane;
        f32x4 v[4]; float s = 0.f;
#pragma unroll
        for (int j = 0; j < 4; ++j) { v[j] = __builtin_nontemporal_load(xr + 64 * j); s += (v[j].x * v[j].x + v[j].y * v[j].y) + (v[j].z * v[j].z + v[j].w * v[j].w); }
        const float rstd = 1.f / sqrtf(wave_sum(s) * (1.f / DM) + RMS_EPS);
        unsigned long long* o8 = (unsigned long long*)(XN + (size_t)m * DM) + lane;
#pragma unroll
        for (int j = 0; j < 4; ++j) { const f32x4 y = v[j] * rstd * gv[j]; o8[64 * j] = (unsigned long long)pk2(y.x, y.y) | ((unsigned long long)pk2(y.z, y.w) << 32); }
    }
}

constexpr int KP = 144, VP = 776, K_OFF = 0, V_OFF = 384 * KP, Q_OFF = V_OFF + 64 * VP, ATT_LDS = Q_OFF + 256 * KP;
static_assert(ATT_LDS <= BST_OFF, "attention LDS");
__device__ __forceinline__ int crow(int r, int hi) { return (r & 3) + 8 * (r >> 2) + 4 * hi; }

struct AttnDesc { int R0, L, dsh, g, h, res, q0; };
__device__ __forceinline__ AttnDesc attn_decode(int u, int S) {
    AttnDesc d; const int bps = S / 256; const int gh = u >> 6, blk = u & 63; d.g = gh >> 3; d.h = gh & 7;
    const int seq = blk / bps, bl = blk % bps; d.R0 = seq * S; d.dsh = 2 * d.g; d.L = S >> d.dsh;
    const int Lb = d.L / 256; d.res = bl / Lb; d.q0 = (bl % Lb) * 256; return d;
}
__device__ __forceinline__ void attn_load(const AttnDesc& d, const bf16* QKV, int tid, u32x4 (&kr)[6], u32x4 (&va)[3], u32x4 (&vb)[3], u32x4 (&qc)[4]) {
    const int lane = tid & 63, wid = tid >> 6, ql = lane & 31, hi = lane >> 5, dil = 1 << d.dsh;
    const bf16* Kg = QKV + 1536 + d.g * 512 + d.h * 64; const bf16* Vg = Kg + 1536;
#pragma unroll
    for (int j = 0; j < 4; ++j) { const int c = tid + 512 * j, i = c >> 3, ch = c & 7;
        qc[j] = *(const u32x4*)(QKV + (size_t)(d.R0 + (d.q0 + i) * dil + d.res) * QP + d.g * 512 + d.h * 64 + ch * 8); }
#pragma unroll
    for (int j = 0; j < 6; ++j) { const int c = tid + 512 * j, i = c >> 3, ch = c & 7, pos = d.q0 - 64 + i;
        const int pc = min(max(pos, 0), d.L - 1);
        kr[j] = *(const u32x4*)(Kg + (size_t)(d.R0 + pc * dil + d.res) * QP + ch * 8); }
#pragma unroll
    for (int j = 0; j < 3; ++j) { const int c = tid + 512 * j, kp = c >> 3, ch = c & 7, pos = d.q0 - 64 + 2 * kp;
        const int pc = min(max(pos, 0), d.L - 2);
        const bf16* src = Vg + (size_t)(d.R0 + pc * dil + d.res) * QP + ch * 8; va[j] = *(const u32x4*)src; vb[j] = *(const u32x4*)(src + (size_t)dil * QP); }
}
__device__ __forceinline__ void attn_stage(LAS unsigned char* lds, int tid, const u32x4 (&kr)[6], const u32x4 (&va)[3], const u32x4 (&vb)[3], const u32x4 (&qc)[4]) {
#pragma unroll
    for (int j = 0; j < 4; ++j) { const int c = tid + 512 * j, i = c >> 3, ch = c & 7; *(LAS u32x4*)(lds + Q_OFF + i * KP + ch * 16) = qc[j]; }
#pragma unroll
    for (int j = 0; j < 6; ++j) { const int c = tid + 512 * j, i = c >> 3, ch = c & 7; *(LAS u32x4*)(lds + K_OFF + i * KP + ch * 16) = kr[j]; }
#pragma unroll
    for (int j = 0; j < 3; ++j) { const int c = tid + 512 * j, kp = c >> 3, ch = c & 7;
        LAS unsigned char* dst = lds + V_OFF + (ch * 8) * VP + kp * 4;
#pragma unroll
        for (int e = 0; e < 4; ++e) { const unsigned wa = va[j][e], wb = vb[j][e];
            *(LAS unsigned*)(dst + (2 * e) * VP) = (wa & 0xffffu) | (wb << 16);
            *(LAS unsigned*)(dst + (2 * e + 1) * VP) = (wa >> 16) | (wb & 0xffff0000u); } }
}
__device__ __forceinline__ void attn_compute(LAS unsigned char* lds, const AttnDesc& d, bf16* OB, float* LSE, int tid_in) {
    int tid = tid_in; asm volatile("" : "+v"(tid));
    const int lane = tid & 63, wid = tid >> 6, ql = lane & 31, hi = lane >> 5, dil = 1 << d.dsh;
    const int qpos = d.q0 + 32 * wid + ql;
    const size_t qrow = (size_t)(d.R0 + qpos * dil + d.res);
    LAS unsigned char* qimg = lds + Q_OFF + (32 * wid) * KP;
    bf16x8 qr[4];
#pragma unroll
    for (int d0 = 0; d0 < 4; ++d0) qr[d0] = *(const LAS bf16x8*)(qimg + ql * KP + d0 * 32 + hi * 16);
    const float slope = exp2f(-(float)(d.g * 8 + d.h + 1) * (1.0f / 3.0f));
    const float sl2 = slope * (float)dil * 1.4426950408889634f;
    float lanef = (float)(4 * hi - ql); asm volatile("" : "+v"(lanef));
    const float qposf = (float)qpos;
    const float lo = fmaxf(-64.f, -qposf), hi_ = fminf(64.f, (float)(d.L - 1) - qposf);
    const bool edge_lo = (d.q0 == 0), edge_hi = (d.q0 + 256 >= d.L);
    typedef float f32x2 __attribute__((ext_vector_type(2)));
    const f32x2 lane2 = (f32x2){lanef, lanef};
    float mx = -3.0e38f, lsum = 0.f;
    f32x16 o[2]; o[0] = f32x16{}; o[1] = f32x16{};
#pragma unroll
    for (int bi = 0; bi < 5; ++bi) {
        const int b = bi == 0 ? 2 : bi == 1 ? 1 : bi == 2 ? 3 : bi == 3 ? 0 : 4;
        const LAS unsigned char* kb = lds + K_OFF + (32 * wid + 32 * b + ql) * KP + hi * 16;
        f32x16 a = {};
#pragma unroll
        for (int d0 = 0; d0 < 4; ++d0) { const bf16x8 kf = *(const LAS bf16x8*)(kb + d0 * 32); a = __builtin_amdgcn_mfma_f32_32x32x16_bf16(kf, qr[d0], a, 0, 0, 0); }
        f32x2 t2[8];
#pragma unroll
        for (int r = 0; r < 16; r += 2) { const float c0 = (float)(-64 + 32 * b + (r & 3) + 8 * (r >> 2));
            t2[r >> 1] = (f32x2){c0, c0 + 1.f} + lane2;
            f32x2 v = (f32x2){a[r], a[r + 1]};
            if (b < 2) v = v + t2[r >> 1] * sl2; else if (b > 2) v = v - t2[r >> 1] * sl2;
            else { v.x -= sl2 * __builtin_fabsf(t2[r >> 1].x); v.y -= sl2 * __builtin_fabsf(t2[r >> 1].y); }
            a[r] = v.x; a[r + 1] = v.y; }
        if (b == 0 || (edge_lo && b <= 2)) {
#pragma unroll
            for (int r = 0; r < 16; ++r) { const float t = (r & 1) ? t2[r >> 1].y : t2[r >> 1].x; a[r] = (t >= lo) ? a[r] : -1.0e30f; } }
        if (b == 4 || (edge_hi && b >= 2)) {
#pragma unroll
            for (int r = 0; r < 16; ++r) { const float t = (r & 1) ? t2[r >> 1].y : t2[r >> 1].x; a[r] = (t <= hi_) ? a[r] : -1.0e30f; } }
        float bm = fmaxf(fmaxf(a[0], a[1]), a[2]);
#pragma unroll
        for (int r = 3; r < 15; r += 2) bm = fmaxf(fmaxf(bm, a[r]), a[r + 1]);
        bm = fmaxf(bm, a[15]);
        bm = fmaxf(bm, __shfl_xor(bm, 32));
        if (bi == 0) mx = bm;
        else if (__any(bm > mx + 8.f)) { const float mn = fmaxf(mx, bm); const float alpha = __builtin_amdgcn_exp2f(mx - mn); lsum *= alpha;
#pragma unroll
            for (int r = 0; r < 16; ++r) { o[0][r] *= alpha; o[1][r] *= alpha; }
            mx = mn; }
        const f32x2 m2 = (f32x2){mx, mx};
        f32x2 ls2 = (f32x2){0.f, 0.f};
#pragma unroll
        for (int r = 0; r < 16; r += 2) { const f32x2 dlt = (f32x2){a[r], a[r + 1]} - m2; f32x2 e; e.x = __builtin_amdgcn_exp2f(dlt.x); e.y = __builtin_amdgcn_exp2f(dlt.y); a[r] = e.x; a[r + 1] = e.y; ls2 = ls2 + e; }
        lsum += ls2.x + ls2.y;
#pragma unroll
        for (int j = 0; j < 2; ++j) {
            u32x4 pw; pw.x = pg8::cvt_pk_bf16(a[8 * j + 0], a[8 * j + 1]); pw.y = pg8::cvt_pk_bf16(a[8 * j + 2], a[8 * j + 3]);
            pw.z = pg8::cvt_pk_bf16(a[8 * j + 4], a[8 * j + 5]); pw.w = pg8::cvt_pk_bf16(a[8 * j + 6], a[8 * j + 7]);
            const bf16x8 pa = __builtin_bit_cast(bf16x8, pw);
#pragma unroll
            for (int d0 = 0; d0 < 2; ++d0) {
                const LAS unsigned char* vp = lds + V_OFF + (d0 * 32 + ql) * VP + (32 * wid + 32 * b + 16 * j + 4 * hi) * 2;
                const u32x2 v0 = *(const LAS u32x2*)vp, v1 = *(const LAS u32x2*)(vp + 16);
                const u32x4 vw = (u32x4){v0.x, v0.y, v1.x, v1.y};
                o[d0] = __builtin_amdgcn_mfma_f32_32x32x16_bf16(__builtin_bit_cast(bf16x8, vw), pa, o[d0], 0, 0, 0);
            }
        }
    }
    lsum += __shfl_xor(lsum, 32);
    const float inv = 1.f / lsum;
#pragma unroll
    for (int d0 = 0; d0 < 2; ++d0)
#pragma unroll
        for (int k = 0; k < 4; ++k) { u32x2 w; w.x = pg8::cvt_pk_bf16(o[d0][4 * k] * inv, o[d0][4 * k + 1] * inv); w.y = pg8::cvt_pk_bf16(o[d0][4 * k + 2] * inv, o[d0][4 * k + 3] * inv);
            *(LAS u32x2*)(qimg + ql * KP + (d0 * 32 + 8 * k + 4 * hi) * 2) = w; }
    asm volatile("s_waitcnt lgkmcnt(0)" ::: "memory");
#pragma unroll
    for (int j = 0; j < 4; ++j) { const int idx = lane + 64 * j, r = idx >> 3, ch = idx & 7;
        const u32x4 v = *(const LAS u32x4*)(qimg + r * KP + ch * 16);
        *(u32x4*)(OB + (size_t)(d.R0 + (d.q0 + 32 * wid + r) * dil + d.res) * 1536 + d.g * 512 + d.h * 64 + ch * 8) = v; }
    if (hi == 0) LSE[qrow * 24 + d.g * 8 + d.h] = mx + log2f(lsum);
}

__device__ __forceinline__ void phase_attention(const Params& p, LAS unsigned char* lds, int chunk, int G, int tid_in) {
    int tid = tid_in; asm volatile("" : "+v"(tid));
    const bf16* QKV = (const bf16*)(p.ws + WS_QKV); bf16* OB = (bf16*)(p.ws + WS_OB); float* LSE = (float*)(p.ws + WS_LSE);
    const int S = chunk == 0 ? 16384 : 8192;
    constexpr int NU = 24 * 64;
    int u = (G % 8 == 0) ? ((int)blockIdx.x % 8) * (G / 8) + (int)blockIdx.x / 8 : (int)blockIdx.x;
    if (u >= NU) return;
    u32x4 kr[6], va[3], vb[3], qn[4];
    AttnDesc d = attn_decode(u, S);
    attn_load(d, QKV, tid, kr, va, vb, qn);
    for (;;) {
        attn_stage(lds, tid, kr, va, vb, qn);
        __syncthreads();
        const int un = u + G; const bool has_next = un < NU;
        AttnDesc dn = d;
        if (has_next) { dn = attn_decode(un, S); attn_load(dn, QKV, tid, kr, va, vb, qn); }
        attn_compute(lds, d, OB, LSE, tid);
        if (!has_next) break;
        __syncthreads();
        d = dn; u = un;
    }
    __syncthreads();
}

__device__ __forceinline__ void phase_combine(const Params& p, int chunk, int row_begin, int nrows, int lane_in) {
    int lane = lane_in; asm volatile("" : "+v"(lane));
    const bf16* OB = (const bf16*)(p.ws + WS_OB); const float* LSE = (const float*)(p.ws + WS_LSE);
    const bf16* ZA = (const bf16*)(p.ws + (chunk == 0 ? WS_ZA : WS_ZA2)); const bf16* U = (const bf16*)(p.ws + WS_U); const bf16* T = (const bf16*)(p.ws + WS_T);
    const __amdgpu_buffer_rsrc_t a12_r = __builtin_amdgcn_make_buffer_rsrc((void*)(p.ws + WS_A12), 0, 2 * CH * 512 * 2, 0x00020000);
    const int S = chunk == 0 ? 16384 : 8192;
    f32x4 cw[3][2];
#pragma unroll
    for (int k = 0; k < 3; ++k) { cw[k][0] = *(const f32x4*)(p.conv_w + k * 512 + 8 * lane); cw[k][1] = *(const f32x4*)(p.conv_w + k * 512 + 8 * lane + 4); }
    const int hs = lane >> 3;
#pragma unroll 4
    for (int ri = 0; ri < nrows; ++ri) {
        const int row = row_begin + ri;
        const int s = row & (S - 1);
        const u32x4 zero = (u32x4){0u, 0u, 0u, 0u};
        const float l0 = LSE[(size_t)row * 24 + hs], l1 = LSE[(size_t)row * 24 + 8 + hs], l2 = LSE[(size_t)row * 24 + 16 + hs];
        const u32x4 o0 = __builtin_nontemporal_load((const u32x4*)(OB + (size_t)row * 1536 + 8 * lane)), o1 = __builtin_nontemporal_load((const u32x4*)(OB + (size_t)row * 1536 + 512 + 8 * lane)), o2 = __builtin_nontemporal_load((const u32x4*)(OB + (size_t)row * 1536 + 1024 + 8 * lane));
        const u32x4 za = __builtin_nontemporal_load((const u32x4*)(ZA + (size_t)row * 512 + 8 * lane));
        const u32x4 um = s > 0 ? *(const u32x4*)(U + (size_t)(row - 1) * 512 + 8 * lane) : zero;
        const u32x4 uc = *(const u32x4*)(U + (size_t)row * 512 + 8 * lane);
        const u32x4 up = s < S - 1 ? *(const u32x4*)(U + (size_t)(row + 1) * 512 + 8 * lane) : zero;
        const u32x4 tt = __builtin_nontemporal_load((const u32x4*)(T + (size_t)row * 512 + 8 * lane));
        const float mx = fmaxf(l0, fmaxf(l1, l2));
        float w0 = __builtin_amdgcn_exp2f(l0 - mx), w1 = __builtin_amdgcn_exp2f(l1 - mx), w2 = __builtin_amdgcn_exp2f(l2 - mx);
        const float inv = 1.f / (w0 + w1 + w2); w0 *= inv; w1 *= inv; w2 *= inv;
        f32x4 a0, a1, b0, b1, c0, c1, z0, z1;
        pg8::unpack8(o0, a0, a1); pg8::unpack8(o1, b0, b1); pg8::unpack8(o2, c0, c1); pg8::unpack8(za, z0, z1);
        const f32x4 r0 = z0 * (a0 * w0 + b0 * w1 + c0 * w2), r1 = z1 * (a1 * w0 + b1 * w1 + c1 * w2);
        pg8::st16_wt(a12_r, (unsigned)(row * 1024 + 16 * lane), pg8::pack8(r0, r1));
        f32x4 m0, m1, e0, e1, n0, n1, t0, t1;
        pg8::unpack8(um, m0, m1); pg8::unpack8(uc, e0, e1); pg8::unpack8(up, n0, n1); pg8::unpack8(tt, t0, t1);
        const f32x4 v0 = t0 * (cw[0][0] * m0 + cw[1][0] * e0 + cw[2][0] * n0), v1 = t1 * (cw[0][1] * m1 + cw[1][1] * e1 + cw[2][1] * n1);
        pg8::st16_wt(a12_r, (unsigned)((CH + row) * 1024 + 16 * lane), pg8::pack8(v0, v1));
    }
}

struct OutOrder {
    pg8::StaticOrder base; unsigned* cnt;
    __device__ bool next(int i, pg8::Unit& u) const { return base.next(i, u); }
    __device__ __forceinline__ void a_ready(const pg8::Unit&) const { pg8::panel_barrier<false>(cnt, 4u); }
    __device__ __forceinline__ void done(const pg8::Unit&) const {}
};
struct MergeOrder {
    pg8::StaticOrder base; int nM, nN; unsigned* cnt;
    __device__ void init(int G, int c) { base.init(CH, DM, G, c); nM = CH / 256; nN = DM / 256; }
    __device__ bool next(int i, pg8::Unit& u) const { pg8::Unit t; if (!base.next(i >> 1, t)) return false; const int h = i & 1; u.pm = t.pm + h * nM; u.pn = t.pn + h * nN; return true; }
    __device__ __forceinline__ void a_ready(const pg8::Unit& u) const { if (u.pm < nM) pg8::panel_barrier<false>(cnt, 4u); }
    __device__ __forceinline__ void done(const pg8::Unit&) const {}
};

#define XB_TMO      128
#define XB_XCNT(j)  (256  + 64 * (j))
#define XB_XSUB(j)  (1280 + 64 * (j))
#define XB_XGEN(j)  (2304 + 64 * (j))
#define XB_TOP      3328
#define XB_TOPGEN   3392
#define XCD_BAR_WORDS 3456
#define XB_SPIN_CAP (1u << 18)

__device__ __forceinline__ unsigned xb_ld(unsigned* p)              { return __hip_atomic_load(p, __ATOMIC_RELAXED, __HIP_MEMORY_SCOPE_AGENT); }
__device__ __forceinline__ unsigned xb_add(unsigned* p, unsigned v) { return __hip_atomic_fetch_add(p, v, __ATOMIC_RELAXED, __HIP_MEMORY_SCOPE_AGENT); }
__device__ __forceinline__ unsigned xb_xcc_id() { return (unsigned)__builtin_amdgcn_s_getreg((3 << 11) | 20) & 0xFu; }
#define XB_SPIN(cond, bar) do { unsigned _sp = 0; while (cond) { __builtin_amdgcn_s_sleep(1); \
    if ((++_sp & 255u) == 0u) { if (xb_ld(&(bar)[XB_TMO])) break; if (_sp > XB_SPIN_CAP) { atomicAdd(&(bar)[XB_TMO], 1u); break; } } } } while (0)

struct XcdBarrier {
    unsigned* bar; unsigned x;
    volatile LAS unsigned* st;
};

__device__ __forceinline__ XcdBarrier xcd_barrier_post(unsigned* bar, volatile LAS unsigned* st) {
    XcdBarrier b; b.bar = bar; b.x = xb_xcc_id(); b.st = st;
    if (threadIdx.x == 0) (void)xb_add(&bar[XB_XCNT(b.x)], 1u);
    return b;
}
__device__ __forceinline__ void xcd_barrier_complete(unsigned* bar, unsigned x, unsigned& nloc, unsigned& nx) {
    const unsigned G = gridDim.x * gridDim.y * gridDim.z;
    unsigned sum, cnt, mine, sp = 0u;
    for (;;) {
        sum = 0u; cnt = 0u; mine = 0u;
#pragma unroll
        for (unsigned j = 0; j < 16; ++j) { const unsigned c = xb_ld(&bar[XB_XCNT(j)]); sum += c; cnt += (c > 0u) ? 1u : 0u; mine = (j == x) ? c : mine; }
        if (sum == G) break;
        __builtin_amdgcn_s_sleep(1);
        if ((++sp & 255u) == 0u) { if (xb_ld(&bar[XB_TMO])) break; if (sp > XB_SPIN_CAP) { atomicAdd(&bar[XB_TMO], 1u); break; } }
    }
    nloc = mine > 0u ? mine : 1u; nx = cnt > 0u ? cnt : 1u;
}

__device__ __forceinline__ void xcd_barrier(const XcdBarrier& b) {
    asm volatile("s_waitcnt vmcnt(0)" ::: "memory");
    __syncthreads();
    if (threadIdx.x == 0) {
        unsigned* bar = b.bar;
        __builtin_amdgcn_s_waitcnt(0);
        unsigned nloc = b.st[0], nx = b.st[1];
        if (nloc == 0u) { xcd_barrier_complete(bar, b.x, nloc, nx); b.st[0] = nloc; b.st[1] = nx; }
        const unsigned old = xb_add(&bar[XB_XSUB(b.x)], 1u);
        const unsigned gen = old / nloc;
        if (old + 1u == (gen + 1u) * nloc) {
            __builtin_amdgcn_fence(__ATOMIC_RELEASE, "agent");
            asm volatile("s_waitcnt vmcnt(0)" ::: "memory");
            const unsigned og = xb_add(&bar[XB_TOP], 1u);
            const unsigned tg = og / nx;
            if (og + 1u == (tg + 1u) * nx) xb_add(&bar[XB_TOPGEN], 1u);
            else XB_SPIN(xb_ld(&bar[XB_TOPGEN]) == tg, bar);
            __builtin_amdgcn_fence(__ATOMIC_ACQUIRE, "agent");
            xb_add(&bar[XB_XGEN(b.x)], 1u);
            asm volatile("s_waitcnt vmcnt(0)" ::: "memory");
        } else {
            XB_SPIN(xb_ld(&bar[XB_XGEN(b.x)]) == gen, bar);
            __builtin_amdgcn_fence(__ATOMIC_ACQUIRE, "agent");
            asm volatile("s_waitcnt vmcnt(0)" ::: "memory");
        }
    }
    __syncthreads();
}

__global__ void __launch_bounds__(NTHREADS, 2) fwd_megakernel(Params p) {
    extern __shared__ __attribute__((aligned(16))) unsigned char lds_raw[];
    LAS unsigned char* lds = (LAS unsigned char*)lds_raw;
    cg::grid_group grid = cg::this_grid();
    const int tid = threadIdx.x, lane = tid & 63, wave = __builtin_amdgcn_readfirstlane(tid >> 6);
    const int G = gridDim.x, gw = blockIdx.x * NWAVES + wave, NGW = G * NWAVES;
    volatile LAS unsigned* bst = (volatile LAS unsigned*)(lds + BST_OFF);
    if (tid < 2) bst[tid] = 0u;
    unsigned* ctl = (unsigned*)(p.ws + WS_BAR);
    constexpr unsigned READY_MAGIC = 0x600DF1A6u;
    unsigned* ready = ctl + CTL_WORDS;
    if (p.use_cg_sync) grid.sync();
    if (blockIdx.x == 0) {
        for (int i = tid; i < CTL_WORDS / 64; i += NTHREADS) __hip_atomic_store(ctl + 64 * i, 0u, __ATOMIC_RELAXED, __HIP_MEMORY_SCOPE_AGENT);
        asm volatile("s_waitcnt vmcnt(0)" ::: "memory");
        __syncthreads();
        if (tid == 0) __hip_atomic_store(ready, READY_MAGIC, __ATOMIC_RELAXED, __HIP_MEMORY_SCOPE_AGENT);
    } else {
        if (tid == 0) { unsigned sp = 0u; while (__hip_atomic_load(ready, __ATOMIC_RELAXED, __HIP_MEMORY_SCOPE_AGENT) != READY_MAGIC) { __builtin_amdgcn_s_sleep(1); if (++sp > (1u << 24)) break; }
        }
        __syncthreads();
    }
    const XcdBarrier bar = xcd_barrier_post(ctl, bst);

    phase_prologue(p, lds, gw, NGW, wave, lane);
    xcd_barrier(bar);

    pg8::StaticOrder St; St.init(CH, DM, G, (int)blockIdx.x);
    pg8::Unit tu; const bool has_tile = St.next(0, tu);
    const bool tail_first = true;
    const unsigned long long prog = tail_first ? 0x6353423130ull   : 0x6353243130ull  ;
    for (int step = 0; step < 10; ++step) {
        const int code = (int)((prog >> (4 * step)) & 15ull), op = code & 3, chunk = code >> 2;
        const pg8::bf16_t* XNc = (const pg8::bf16_t*)(p.ws + WS_XN) + (size_t)chunk * CH * DM;
        pg8::EpiP1 E1{(pg8::bf16_t*)(p.ws + WS_QKV), (pg8::bf16_t*)(p.ws + (chunk == 0 ? WS_ZA : WS_ZA2)), (pg8::bf16_t*)(p.ws + WS_U), (pg8::bf16_t*)(p.ws + WS_T), (pg8::bf16_t*)(p.ws + WS_GR), (pg8::bf16_t*)(p.ws + WS_GC), p.b_gate, 0};
        if (op == 3) { xcd_barrier(bar); }
        else if (op == 0) {
            pg8::Gemm g{XNc, (const pg8::bf16_t*)(p.ws + WS_WIN), CH, 20 * 256, DM};
            pg8::StaticOrder S; S.init(CH, 20 * 256, G, (int)blockIdx.x);
            pg8::gemm_phase<pg8::EpiP1, pg8::StaticOrder, true, true>(lds, g, S, E1);
            __syncthreads();
        } else if (op == 1) {
            phase_attention(p, lds, chunk, G, tid);
            {
                pg8::Gemm g{XNc, (const pg8::bf16_t*)(p.ws + WS_WIN) + (size_t)20 * 256 * DM, CH, 16 * 256, DM};
                pg8::StaticOrder S; S.init(CH, 16 * 256, G, (int)blockIdx.x);
                pg8::EpiP1 E2 = E1; E2.pn_off = 20;
                pg8::gemm_phase<pg8::EpiP1, pg8::StaticOrder, true, true>(lds, g, S, E2);
            }
        } else if (has_tile) {
            unsigned* pcnt = ctl + PANEL_CNT0 + (size_t)chunk * 64 * 3 * 64;
            int tl_ = (int)threadIdx.x; asm volatile("" : "+v"(tl_));
            phase_combine(p, chunk, tu.pm * 256 + tu.pn * 64 + wave * 8, 8, tl_ & 63);
            asm volatile("s_waitcnt vmcnt(0)" ::: "memory");
            {
                pg8::Gemm g{(const pg8::bf16_t*)(p.ws + WS_A12), (const pg8::bf16_t*)(p.ws + WS_WAC), 2 * CH, 2 * DM, 512};
                MergeOrder S; S.init(G, (int)blockIdx.x); S.cnt = pcnt + (size_t)tu.pm * 3 * 64 + 0 * 64;
                pg8::EpiMerge E{(const pg8::bf16_t*)(p.ws + WS_GR), (const pg8::bf16_t*)(p.ws + WS_GC), (pg8::bf16_t*)(p.ws + WS_MG), CH / 256, DM / 256};
                pg8::gemm_phase<pg8::EpiMerge, MergeOrder, true, true>(lds, g, S, E);
            }
            {
                pg8::Gemm g{(const pg8::bf16_t*)(p.ws + WS_MG), (const pg8::bf16_t*)(p.ws + WS_WO), CH, DM, DM};
                pg8::EpiOutNorm E{chunk == 0 ? p.x_prompt : p.x_sample, p.out + (size_t)chunk * CH * DM, p.final_g, (float*)(p.ws + WS_XB) + (size_t)chunk * 64 * 256 * 4, pcnt + 2 * 64};
                OutOrder So{St, pcnt + (size_t)tu.pm * 3 * 64 + 1 * 64};
                pg8::gemm_phase<pg8::EpiOutNorm, OutOrder, false, true>(lds, g, So, E);
            }
            __syncthreads();
        }
    }
    if (blockIdx.x == 0 && tid == 0) __hip_atomic_store(ready, 0u, __ATOMIC_RELAXED, __HIP_MEMORY_SCOPE_AGENT);
}

extern "C" void kernel_launch(void* const* d_in, const int* in_sizes, int n_in, void* d_out, int out_size, void* d_ws, size_t ws_size, hipStream_t stream) {
    static int grid = 0;
    if (grid == 0) {
        if (n_in != 10 || out_size != NTOK * DM || ws_size < WS_END) { fprintf(stderr, "kernel_launch: unexpected shapes / workspace (%d inputs, out %d, ws %zu)\n", n_in, out_size, ws_size); grid = -1; return; }
        int dev = 0, cus = 0, per_cu = 0;
        if (hipGetDevice(&dev) != hipSuccess || hipDeviceGetAttribute(&cus, hipDeviceAttributeMultiprocessorCount, dev) != hipSuccess) { grid = -1; return; }
        if (hipFuncSetAttribute((const void*)fwd_megakernel, hipFuncAttributeMaxDynamicSharedMemorySize, LDS_BYTES) != hipSuccess) { fprintf(stderr, "kernel_launch: hipFuncSetAttribute failed\n"); grid = -1; return; }
        if (hipOccupancyMaxActiveBlocksPerMultiprocessor(&per_cu, (const void*)fwd_megakernel, NTHREADS, LDS_BYTES) != hipSuccess || per_cu < 1) { fprintf(stderr, "kernel_launch: occupancy query says %d\n", per_cu); per_cu = 1; }
        (void)hipGetLastError();
        grid = cus;
    }
    if (grid < 0) return;
    Params p{};
    p.x_prompt = (const float*)d_in[0]; p.x_sample = (const float*)d_in[1]; p.norm_g = (const float*)d_in[2]; p.w_in = (const float*)d_in[3]; p.b_gate = (const float*)d_in[4];
    p.conv_w = (const float*)d_in[5]; p.w_attn_out = (const float*)d_in[6]; p.w_conv_out = (const float*)d_in[7]; p.w_o = (const float*)d_in[8]; p.final_g = (const float*)d_in[9];
    p.out = (float*)d_out; p.ws = (unsigned char*)d_ws;
    void* args[] = {&p};
    hipError_t e = hipLaunchCooperativeKernel((const void*)fwd_megakernel, dim3(grid), dim3(NTHREADS), args, LDS_BYTES, stream);
    if (e != hipSuccess) fprintf(stderr, "kernel_launch: cooperative launch failed: %s (grid %d)\n", hipGetErrorString(e), grid);
}
```
